# Optimizing an MI355X kernel written in HIP

```python
import math
import jax, jax.numpy as jnp
from jax import lax
import numpy as np

D_MODEL = 1024
BATCH = 8
SEQ = 4096
DEPTH = 4

N_META = 16
SSM_WIDTH = D_MODEL // 2
SSM_GROUP = 16
SSM_GROUPS = SSM_WIDTH // SSM_GROUP
SSM_STATE = 64
GLA_HEADS = 4
GLA_VDIM = D_MODEL // 2
GLA_KDIM = GLA_VDIM // 2
GLA_HK = GLA_KDIM // GLA_HEADS
GLA_HV = GLA_VDIM // GLA_HEADS
GLA_GATE_RANK = 16
GLA_GATE_TAU = 16.0
GLA_CHUNK = 64
D_FF = -(-8 * D_MODEL // (3 * 256)) * 256
EPS = 1e-6
SPLIT_SIZES = (SSM_WIDTH, GLA_KDIM, GLA_KDIM, GLA_VDIM, GLA_VDIM, GLA_GATE_RANK, D_MODEL, D_MODEL)
IN_COLS = SSM_WIDTH + 2 * GLA_KDIM + 2 * GLA_VDIM + GLA_GATE_RANK + 2 * D_MODEL

kernel_name = "hybrid_s5_gla_gated_trunk"


def rmsnorm(x, gain):
    xf = x.astype(jnp.float32)
    y = xf * lax.rsqrt(jnp.mean(xf * xf, axis=-1, keepdims=True) + EPS)
    return (y * gain.astype(jnp.float32)).astype(x.dtype)


def split_cols(z):
    idx = [int(i) for i in np.cumsum(SPLIT_SIZES)[:-1]]
    return jnp.split(z, idx, axis=-1)


def _cmul_scan_op(e1, e2):
    a1r, a1i, b1r, b1i = e1
    a2r, a2i, b2r, b2i = e2
    return (a2r * a1r - a2i * a1i,
            a2r * a1i + a2i * a1r,
            a2r * b1r - a2i * b1i + b2r,
            a2r * b1i + a2i * b1r + b2i)


def s5_branch(u, lam_re, lam_im, log_step, b_re, b_im, c_re, c_im, d_skip, w_glu, b_glu):
    f32 = jnp.float32
    bsz, t, _ = u.shape
    uf = u.astype(f32)
    step = jnp.exp(log_step.astype(f32))[:, None]
    lr = jnp.minimum(lam_re.astype(f32), -1e-4)
    li = lam_im.astype(f32)
    mag = jnp.exp(lr * step)
    ab_re = mag * jnp.cos(li * step)
    ab_im = mag * jnp.sin(li * step)
    den = lr * lr + li * li
    nr = ab_re - 1.0
    coef_re = (nr * lr + ab_im * li) / den
    coef_im = (ab_im * lr - nr * li) / den
    br, bi = b_re.astype(f32), b_im.astype(f32)
    bb_re = coef_re[..., None] * br - coef_im[..., None] * bi
    bb_im = coef_re[..., None] * bi + coef_im[..., None] * br
    ug = uf.reshape(bsz, t, SSM_GROUPS, SSM_GROUP)
    bu_re = jnp.einsum('btgh,gph->btgp', ug, bb_re)
    bu_im = jnp.einsum('btgh,gph->btgp', ug, bb_im)
    a_re = jnp.broadcast_to(ab_re, bu_re.shape)
    a_im = jnp.broadcast_to(ab_im, bu_re.shape)
    _, _, xs_re, xs_im = lax.associative_scan(_cmul_scan_op, (a_re, a_im, bu_re, bu_im), axis=1)
    y = (jnp.einsum('btgp,ghp->btgh', xs_re, c_re.astype(f32))
         - jnp.einsum('btgp,ghp->btgh', xs_im, c_im.astype(f32)))
    y = y.reshape(bsz, t, SSM_WIDTH) + d_skip.astype(f32) * uf
    act = jax.nn.gelu(y)
    out = act * jax.nn.sigmoid(act @ w_glu.astype(f32) + b_glu.astype(f32))
    return out.astype(u.dtype)


def gla_branch(q, k, v, r, a_low, w_alpha, b_alpha, norm_gain):
    f32 = jnp.float32
    bsz, t, _ = q.shape
    log_a = jax.nn.log_sigmoid((a_low @ w_alpha + b_alpha).astype(f32)) / GLA_GATE_TAU
    pad = GLA_CHUNK - N_META

    def chunks(z, hd):
        z = jnp.pad(z.astype(f32), ((0, 0), (pad, 0), (0, 0)))
        n = z.shape[1] // GLA_CHUNK
        return z.reshape(bsz, n, GLA_CHUNK, GLA_HEADS, hd).transpose(0, 3, 1, 2, 4)

    qc = chunks(q, GLA_HK) * (GLA_HK ** -0.5)
    kc = chunks(k, GLA_HK)
    vc = chunks(v, GLA_HV)
    gc = chunks(log_a, GLA_HK)
    bcum = jnp.cumsum(gc, axis=3)
    b_last = bcum[:, :, :, -1:, :]
    q_dec = qc * jnp.exp(bcum)
    k_intra = kc * jnp.exp(-bcum)
    k_state = kc * jnp.exp(b_last - bcum)
    causal = jnp.tril(jnp.ones((GLA_CHUNK, GLA_CHUNK), dtype=bool))
    scores = jnp.where(causal, jnp.einsum('bhncd,bhnsd->bhncs', q_dec, k_intra), 0.0)
    o_intra = jnp.einsum('bhncs,bhnse->bhnce', scores, vc)
    kv = jnp.einsum('bhncd,bhnce->bhnde', k_state, vc)
    decay = jnp.exp(b_last[:, :, :, 0, :])

    def step(state, inp):
        dec, kv_n = inp
        return dec[..., None] * state + kv_n, state

    init = jnp.zeros((bsz, GLA_HEADS, GLA_HK, GLA_HV), f32)
    _, s_prev = lax.scan(step, init, (jnp.moveaxis(decay, 2, 0), jnp.moveaxis(kv, 2, 0)))
    s_prev = jnp.moveaxis(s_prev, 0, 2)
    o = o_intra + jnp.einsum('bhncd,bhnde->bhnce', q_dec, s_prev)
    o = o.transpose(0, 2, 3, 1, 4).reshape(bsz, -1, GLA_HEADS, GLA_HV)[:, pad:]
    o = o * lax.rsqrt(jnp.mean(o * o, axis=-1, keepdims=True) + EPS)
    o = o.reshape(bsz, t, GLA_VDIM) * norm_gain.astype(f32)
    return (jax.nn.silu(r.astype(f32)) * o).astype(q.dtype)


def setup_inputs(seed: int = 0) -> dict:
    key = jax.random.key(seed)
    ks = jax.random.split(key, 28)
    nrm = jax.random.normal
    L, G, P, H = DEPTH, SSM_GROUPS, SSM_STATE, SSM_GROUP
    x = nrm(ks[0], (BATCH, SEQ, D_MODEL), jnp.float32)
    meta = nrm(ks[1], (N_META, D_MODEL), jnp.float32)
    norm1 = 1.0 + 0.02 * nrm(ks[2], (L, D_MODEL), jnp.float32)
    w_in = nrm(ks[3], (L, D_MODEL, IN_COLS), jnp.float32) * D_MODEL ** -0.5
    lam_re = -0.5 + 0.01 * nrm(ks[4], (L, G, P), jnp.float32)
    lam_im = math.pi * jnp.arange(P, dtype=jnp.float32) + 0.01 * nrm(ks[5], (L, G, P), jnp.float32)
    log_step = jax.random.uniform(ks[6], (L, G), jnp.float32, math.log(1e-3), math.log(1e-1))
    b_re = nrm(ks[7], (L, G, P, H), jnp.float32) * (2 * H) ** -0.5
    b_im = nrm(ks[8], (L, G, P, H), jnp.float32) * (2 * H) ** -0.5
    c_re = nrm(ks[9], (L, G, H, P), jnp.float32) * P ** -0.5
    c_im = nrm(ks[10], (L, G, H, P), jnp.float32) * P ** -0.5
    d_skip = nrm(ks[11], (L, SSM_WIDTH), jnp.float32)
    w_glu = nrm(ks[12], (L, SSM_WIDTH, SSM_WIDTH), jnp.float32) * SSM_WIDTH ** -0.5
    b_glu = 0.01 * nrm(ks[13], (L, SSM_WIDTH), jnp.float32)
    w_pa = nrm(ks[14], (L, SSM_WIDTH, D_MODEL), jnp.float32) * SSM_WIDTH ** -0.5
    w_alpha = nrm(ks[15], (L, GLA_GATE_RANK, GLA_KDIM), jnp.float32) * GLA_GATE_RANK ** -0.5
    b_alpha = 0.01 * nrm(ks[16], (L, GLA_KDIM), jnp.float32)
    gla_norm = 1.0 + 0.02 * nrm(ks[17], (L, GLA_VDIM), jnp.float32)
    w_pb = nrm(ks[18], (L, GLA_VDIM, D_MODEL), jnp.float32) * GLA_VDIM ** -0.5
    w_out = nrm(ks[19], (L, D_MODEL, D_MODEL), jnp.float32) * D_MODEL ** -0.5
    norm2 = 1.0 + 0.02 * nrm(ks[20], (L, D_MODEL), jnp.float32)
    w_ff1 = nrm(ks[21], (L, D_MODEL, D_FF), jnp.float32) * D_MODEL ** -0.5
    w_ff3 = nrm(ks[22], (L, D_MODEL, D_FF), jnp.float32) * D_MODEL ** -0.5
    w_ff2 = nrm(ks[23], (L, D_FF, D_MODEL), jnp.float32) * D_FF ** -0.5
    norm_f = 1.0 + 0.02 * nrm(ks[24], (D_MODEL,), jnp.float32)
    return {"x": x, "meta": meta, "norm1": norm1, "w_in": w_in, "lam_re": lam_re, "lam_im": lam_im,
            "log_step": log_step, "b_re": b_re, "b_im": b_im, "c_re": c_re, "c_im": c_im,
            "d_skip": d_skip, "w_glu": w_glu, "b_glu": b_glu, "w_pa": w_pa, "w_alpha": w_alpha,
            "b_alpha": b_alpha, "gla_norm": gla_norm, "w_pb": w_pb, "w_out": w_out, "norm2": norm2,
            "w_ff1": w_ff1, "w_ff3": w_ff3, "w_ff2": w_ff2, "norm_f": norm_f}


def reference(x, meta, norm1, w_in, lam_re, lam_im, log_step, b_re, b_im, c_re, c_im, d_skip,
              w_glu, b_glu, w_pa, w_alpha, b_alpha, gla_norm, w_pb, w_out, norm2,
              w_ff1, w_ff3, w_ff2, norm_f):
    bsz = x.shape[0]
    meta_b = jnp.broadcast_to(meta.astype(x.dtype)[None], (bsz, N_META, D_MODEL))
    h = jnp.concatenate([meta_b, x], axis=1)
    for l in range(DEPTH):
        z = rmsnorm(h, norm1[l])
        u, q, k, v, r, a_low, g_a, g_b = split_cols(z @ w_in[l])
        y_a = s5_branch(u, lam_re[l], lam_im[l], log_step[l], b_re[l], b_im[l], c_re[l], c_im[l],
                        d_skip[l], w_glu[l], b_glu[l]) @ w_pa[l]
        y_b = gla_branch(q, k, v, r, a_low, w_alpha[l], b_alpha[l], gla_norm[l]) @ w_pb[l]
        mixed = jax.nn.sigmoid(g_a) * y_a + jax.nn.sigmoid(g_b) * y_b
        h = h + mixed @ w_out[l]
        z2 = rmsnorm(h, norm2[l])
        h = h + (jax.nn.silu(z2 @ w_ff1[l]) * (z2 @ w_ff3[l])) @ w_ff2[l]
    return rmsnorm(h, norm_f)[:, N_META:]
```

```cpp
#include <hip/hip_runtime.h>
#include <hip/hip_cooperative_groups.h>
#include <cstdio>
namespace cg = cooperative_groups;

#ifndef MK_DRY_S5ONLY
#define MK_DRY_S5ONLY 0
#endif
#ifndef MK_DUP_DRY
#define MK_DUP_DRY 0
#endif
#ifndef MK_DUP
#define MK_DUP -1
#endif
#ifndef MK_NO_GSCAN
#define MK_NO_GSCAN 0
#endif
#ifndef MK_NO_INTER
#define MK_NO_INTER 0
#endif
#ifndef MK_BRANCH
#define MK_BRANCH 0
#endif
#ifndef MK_LAYERS
#define MK_LAYERS 4
#endif
#ifndef MK_LAST_S
#define MK_LAST_S 10
#endif
#ifndef MK_ONE_LAUNCH
#define MK_ONE_LAUNCH 1
#endif

#define LAS __attribute__((address_space(3)))
typedef unsigned short bf16_t;
typedef short bf16x8 __attribute__((ext_vector_type(8)));
typedef float f32x4 __attribute__((ext_vector_type(4)));
typedef float f32x2 __attribute__((ext_vector_type(2)));
typedef unsigned u32x4 __attribute__((ext_vector_type(4)));
typedef unsigned u32x2 __attribute__((ext_vector_type(2)));

constexpr int DM = 1024, NBATCH = 8, SEQ = 4096, NMETA = 16, DEPTH = 4;
constexpr int TB = 4128;
constexpr int MP = NBATCH * TB;
constexpr int NPROJ = 4352;
constexpr int DFF = 2816;
constexpr int C_U = 0, C_Q = 512, C_K = 768, C_V = 1024, C_R = 1536, C_GL = 2048, C_GA = 2304, C_GB = 3328;
constexpr int C_GLU = 512;
constexpr int NCH16 = MP / 16;
constexpr int GCH = 66;
constexpr float EPS = 1e-6f;

constexpr size_t WS_H = 0;
constexpr size_t WS_PROJ = WS_H + (size_t)MP * DM * 4;
constexpr size_t WS_W = WS_PROJ + (size_t)MP * NPROJ * 2 + 65536;
constexpr size_t W_IN = 0, W_GLU = W_IN + (size_t)NPROJ * 1024, W_PA = W_GLU + 512 * 512, W_PB = W_PA + 1024 * 512, W_OUT = W_PB + 1024 * 512,
                 W_FF13 = W_OUT + 1024 * 1024, W_FF2 = W_FF13 + (size_t)2 * DFF * 1024, W_END = W_FF2 + (size_t)1024 * DFF;
constexpr size_t WS_XLOC = WS_W + W_END * 2;
constexpr size_t WS_WY = WS_XLOC + (size_t)NCH16 * 32 * 128 * 4;
constexpr size_t WS_WE = WS_WY + (size_t)32 * 256 * 384 * 2;
constexpr size_t WS_A16 = WS_WE + (size_t)32 * 128 * 256 * 2;
constexpr size_t WS_DECAY = WS_A16 + 32 * 64 * 2 * 4;
constexpr size_t WS_PART = WS_DECAY + (size_t)32 * GCH * 64 * 4;
constexpr size_t WS_BAR = WS_PART + (size_t)11 * 256 * 1024 * 4;
constexpr size_t WS_SSQ1 = WS_BAR + 16384;
constexpr size_t WS_SSQ2 = WS_SSQ1 + (size_t)MP * 16 * 4;
constexpr size_t WS_RS1 = WS_SSQ2 + (size_t)MP * 16 * 4;
constexpr size_t WS_RS2 = WS_RS1 + (size_t)MP * 4;
constexpr size_t WS_TZ = WS_RS2 + (size_t)MP * 4;
constexpr size_t WS_END = WS_TZ + (size_t)32 * 16 * 512 * 2;
constexpr size_t WS_Y = WS_PROJ + (size_t)MP * DFF * 2;
constexpr size_t OS_Z = 0;
constexpr size_t OS_KVT = (size_t)MP * DM * 2;
constexpr size_t OS_END = OS_KVT + (size_t)32 * GCH * 8192 * 2;
static_assert(OS_END <= (size_t)NBATCH * SEQ * DM * 4, "d_out scratch overflow");
static_assert(WS_END <= (size_t)512 * 1024 * 1024, "workspace overflow");

constexpr int LDS_BYTES = 131072 + 16;

struct Params {
    const float *x, *meta, *norm1, *w_in, *lam_re, *lam_im, *log_step, *b_re, *b_im, *c_re, *c_im, *d_skip, *w_glu, *b_glu, *w_pa, *w_alpha, *b_alpha,
        *gla_norm, *w_pb, *w_out, *norm2, *w_ff1, *w_ff3, *w_ff2, *norm_f;
    float* out; unsigned char* ws; int ph_lo, ph_hi, bid, nblk, dry, pad_;
};

__device__ __forceinline__ float bf2f(bf16_t b) { return __uint_as_float(((unsigned)b) << 16); }
__device__ __forceinline__ float bflo(unsigned w) { return __uint_as_float(w << 16); }
__device__ __forceinline__ float bfhi(unsigned w) { return __uint_as_float(w & 0xffff0000u); }
typedef __bf16 bf16n2 __attribute__((ext_vector_type(2)));
__device__ __forceinline__ unsigned cvt_pk_bf16(float lo, float hi) { const f32x2 f = {lo, hi}; const bf16n2 v = __builtin_convertvector(f, bf16n2); return __builtin_bit_cast(unsigned, v); }
__device__ __forceinline__ bf16_t f2bf(float f) { return (bf16_t)(cvt_pk_bf16(f, 0.f) & 0xffffu); }
__device__ __forceinline__ float sigmoidf_(float x) { return __builtin_amdgcn_rcpf(1.0f + __expf(-x)); }
__device__ __forceinline__ float siluf_(float x) { return x * sigmoidf_(x); }
__device__ __forceinline__ float logsigmoidf_(float x) { return fminf(x, 0.f) - __logf(1.0f + __expf(-fabsf(x))); }
__device__ __forceinline__ float gelu_tanh(float x) { const float u = 0.7978845608f * (x + 0.044715f * x * x * x); return x * sigmoidf_(2.f * u); }
__device__ __forceinline__ f32x4 mfma16(bf16x8 colfrag, bf16x8 rowfrag, f32x4 acc) { return __builtin_amdgcn_mfma_f32_16x16x32_bf16(colfrag, rowfrag, acc, 0, 0, 0); }
__device__ __forceinline__ int otid() { int t = threadIdx.x; asm volatile("" : "+v"(t)); return t; }
__device__ __forceinline__ float shx(float v, int lane, int o) { return __int_as_float(__builtin_amdgcn_ds_bpermute((lane ^ o) << 2, __float_as_int(v))); }

struct RsPre { float rs[2][4]; };
namespace pg8 {
constexpr int BM = 256, BK = 64, HALF = 128, HTB = HALF * BK * 2, STAGE_BYTES = 8 * HTB, NXCD = 8, WGM = 8;
__host__ __device__ __forceinline__ int lds_byte(int r, int c) { const int st = (r >> 4) * 2 + (c >> 5), rr = r & 15, cc = c & 31, ob = rr * 64 + cc * 2; return st * 1024 + (ob ^ (((ob >> 9) & 1) << 5)); }
__host__ __device__ __forceinline__ void stage_rc(int b, int& R, int& C) { const int st = b / 1024, sb = b % 1024, swz = sb ^ (((sb >> 9) & 1) << 5); R = (st >> 1) * 16 + swz / 64; C = (st & 1) * 32 + (swz % 64) / 2; }
__host__ __device__ __forceinline__ int perm32(int rho) { const int n = rho >> 4, i = rho & 15; return 8 * (i >> 2) + 4 * n + (i & 3); }
struct Unit { int pm, pn, k0, nt, split, alt; };
struct Gemm { const bf16_t* A; const bf16_t* Bt; int M, N, K, lda; const bf16_t* A2; const bf16_t* Bt2; };
struct StaticOrder {
    int nM, nN, nwg, G, c, ntK, nsplit, pairs;
    __device__ void init(int M, int N, int K, int G_, int c_, int nsplit_ = 0, int pairs_ = 0) { pairs = pairs_; nM = M / BM - (nsplit_ > 0 ? 1 : 0); nN = N / BM; nwg = nM * nN; G = G_; c = c_; ntK = K / BK; nsplit = nsplit_; }
    __device__ bool next(int i, Unit& u) const {
        const long L = (long)(pairs ? (i >> 1) : i) * G + c; u.alt = pairs ? (i & 1) : 0;
        if (L >= (long)nwg + nsplit * nN) return false;
        const bool tail = L >= nwg; const int j = tail ? (int)(L - nwg) : 0, ns = nsplit > 0 ? nsplit : 1;
        int wgid = tail ? 0 : (int)L; { const int q = nwg / NXCD, r = nwg % NXCD, xcd = wgid % NXCD, off = wgid / NXCD; wgid = (xcd < r ? xcd * (q + 1) : r * (q + 1) + (xcd - r) * q) + off; }
        const int nig = WGM * nN, gid = wgid / nig, fm = gid * WGM, gsz = (nM - fm) < WGM ? (nM - fm) : WGM;
        const int pmf = fm + ((wgid % nig) % gsz), pnf = (wgid % nig) / gsz, ntt = ntK / ns;
        u.pm = tail ? nM : pmf; u.pn = tail ? j % nN : pnf; u.nt = tail ? ntt : ntK; u.k0 = tail ? (j / nN) * ntt * BK : 0; u.split = tail ? (j / nN) + 1 : 0; return true;
    }
};

template <class Epi>
__device__ __forceinline__ void gemm_phase(LAS unsigned char* lds, const Gemm g, const StaticOrder& S, const Epi& E) {
    const int tid = otid();
    const int wid = __builtin_amdgcn_readfirstlane(tid >> 6), lane = tid & 63, wr = wid >> 2, wc = wid & 3, fr = lane & 15, fq = lane >> 4;
    const int K = g.K, lda = g.lda;
    unsigned voffA[2], voffB[2];
#pragma unroll
    for (int i = 0; i < 2; ++i) { int R, C; stage_rc(tid * 16 + i * 8192, R, C); const int Rb = Epi::PERM ? ((R & ~31) + perm32(R & 31)) : R;
        voffA[i] = (unsigned)(R * lda + C) * 2u; voffB[i] = (unsigned)(Rb * K + C) * 2u; }
    const size_t kstep = (size_t)(BK * 2);
    const size_t hA = (size_t)HALF * lda * 2, hB = (size_t)HALF * K * 2;
    const size_t tA = 2 * hA, tB = 2 * hB;
    const unsigned ldsw = (unsigned)wid * 1024u;
    const int aoff = lds_byte(wr * 64 + fr, fq * 8), boff = lds_byte(wc * 32 + fr, fq * 8);
#define PG8_SA(b, h) (((b) * 2 + (h)) * HTB)
#define PG8_SB(b, h) ((4 + (b) * 2 + (h)) * HTB)
#define PG8_STAGE(bufoff, gbase, voff) do { _Pragma("unroll") for (int _i = 0; _i < 2; ++_i) \
        __builtin_amdgcn_global_load_lds((const unsigned*)((const char*)(gbase) + (voff)[_i]), (LAS unsigned*)(lds + (bufoff) + ldsw + _i * 8192), 16, 0, 0); } while (0)
#define PG8_LDA(dst, b, h) do { _Pragma("unroll") for (int m = 0; m < 4; ++m) _Pragma("unroll") for (int k = 0; k < 2; ++k) dst[m][k] = *(const LAS bf16x8*)(lds + PG8_SA(b, h) + aoff + m * 2048 + k * 1024); } while (0)
#define PG8_LDB(dst, b, h) do { _Pragma("unroll") for (int n = 0; n < 2; ++n) _Pragma("unroll") for (int k = 0; k < 2; ++k) dst[n][k] = *(const LAS bf16x8*)(lds + PG8_SB(b, h) + boff + n * 2048 + k * 1024); } while (0)
#define PG8_MMA(ai, bj, At, Bt) do { __builtin_amdgcn_s_setprio(1); _Pragma("unroll") for (int m = 0; m < 4; ++m) _Pragma("unroll") for (int n = 0; n < 2; ++n) _Pragma("unroll") for (int k = 0; k < 2; ++k) \
        acc[ai][bj][m][n] = __builtin_amdgcn_mfma_f32_16x16x32_bf16(Bt[n][k], At[m][k], acc[ai][bj][m][n], 0, 0, 0); __builtin_amdgcn_s_setprio(0); } while (0)
#define PG8_WAIT_V(n) asm volatile("s_waitcnt vmcnt(" #n ")" ::: "memory")
#define PG8_WAIT_L(n) asm volatile("s_waitcnt lgkmcnt(" #n ")" ::: "memory")
#define PG8_BAR __builtin_amdgcn_s_barrier()
#define PG8_SCHED __builtin_amdgcn_sched_barrier(0)
    Unit cur, nxt; int ui = 0;
    if (!S.next(0, cur)) return;
    f32x4 acc[2][2][4][2];
#pragma unroll
    for (int a = 0; a < 2; ++a)
#pragma unroll
        for (int b = 0; b < 2; ++b)
#pragma unroll
            for (int m = 0; m < 4; ++m)
#pragma unroll
                for (int n = 0; n < 2; ++n) acc[a][b][m][n] = (f32x4){0.f, 0.f, 0.f, 0.f};
    bf16x8 At[4][2], B0[2][2], B1[2][2];
    RsPre pre;
    if constexpr (Epi::HAS_PRE) E.pre(pre, cur, wr, fr);
    const char* cA = (const char*)(cur.alt ? g.A2 : g.A) + (size_t)cur.pm * tA + (size_t)cur.k0 * 2; const char* cB = (const char*)(cur.alt ? g.Bt2 : g.Bt) + (size_t)cur.pn * tB + (size_t)cur.k0 * 2;
    PG8_STAGE(PG8_SB(0, 0), cB, voffB); PG8_STAGE(PG8_SA(0, 0), cA, voffA); PG8_STAGE(PG8_SB(0, 1), cB + hB, voffB); PG8_STAGE(PG8_SA(0, 1), cA + hA, voffA);
    if (wr == 1) PG8_BAR;
    PG8_WAIT_V(4); PG8_BAR;
    PG8_STAGE(PG8_SB(1, 0), cB + kstep, voffB); PG8_STAGE(PG8_SA(1, 0), cA + kstep, voffA); PG8_STAGE(PG8_SB(1, 1), cB + hB + kstep, voffB);
    PG8_WAIT_V(6); PG8_BAR;
    for (;;) {
        const bool has_next = S.next(ui + 1, nxt);
        const char* nA = has_next ? (const char*)(nxt.alt ? g.A2 : g.A) + (size_t)nxt.pm * tA + (size_t)nxt.k0 * 2 : cA; const char* nB = has_next ? (const char*)(nxt.alt ? g.Bt2 : g.Bt) + (size_t)nxt.pn * tB + (size_t)nxt.k0 * 2 : cB;
        const int nt = cur.nt;
        for (int t = 0; t < nt; t += 2) {
            const bool last = (t == nt - 2);
            const char* a1 = cA + (size_t)(t + 1) * kstep;
            const char* a2 = last ? nA : cA + (size_t)(t + 2) * kstep; const char* b2 = last ? nB : cB + (size_t)(t + 2) * kstep;
            const char* a3 = a2 + kstep; const char* b3 = b2 + kstep;
            PG8_LDB(B0, 0, 0); PG8_SCHED; PG8_LDA(At, 0, 0); PG8_STAGE(PG8_SA(1, 1), a1 + hA, voffA);
            PG8_WAIT_L(8); PG8_BAR; PG8_WAIT_L(0); PG8_MMA(0, 0, At, B0); PG8_BAR; PG8_SCHED;
            PG8_LDB(B1, 0, 1); PG8_STAGE(PG8_SB(0, 0), b2, voffB);
            PG8_BAR; PG8_WAIT_L(0); PG8_MMA(0, 1, At, B1); PG8_BAR;
            PG8_LDA(At, 0, 1); PG8_STAGE(PG8_SA(0, 0), a2, voffA);
            PG8_BAR; PG8_WAIT_L(0); PG8_MMA(1, 0, At, B0); PG8_BAR; PG8_SCHED;
            PG8_STAGE(PG8_SB(0, 1), b2 + hB, voffB);
            PG8_WAIT_V(6); PG8_BAR; PG8_MMA(1, 1, At, B1); PG8_BAR;
            PG8_LDB(B0, 1, 0); PG8_SCHED; PG8_LDA(At, 1, 0); PG8_STAGE(PG8_SA(0, 1), a2 + hA, voffA);
            PG8_WAIT_L(8); PG8_BAR; PG8_WAIT_L(0); PG8_MMA(0, 0, At, B0); PG8_BAR; PG8_SCHED;
            PG8_LDB(B1, 1, 1); PG8_STAGE(PG8_SB(1, 0), b3, voffB);
            PG8_BAR; PG8_WAIT_L(0); PG8_MMA(0, 1, At, B1); PG8_BAR;
            PG8_LDA(At, 1, 1); PG8_STAGE(PG8_SA(1, 0), a3, voffA);
            PG8_BAR; PG8_WAIT_L(0); PG8_MMA(1, 0, At, B0); PG8_BAR; PG8_SCHED;
            PG8_STAGE(PG8_SB(1, 1), b3 + hB, voffB);
            PG8_WAIT_V(6); PG8_BAR; PG8_MMA(1, 1, At, B1); PG8_BAR;
        }
        if constexpr (Epi::HAS_PRE) { E(acc, cur, wr, wc, fr, fq, pre); if (has_next) E.pre(pre, nxt, wr, fr); } else E(acc, cur, wr, wc, fr, fq);
        if (!has_next) break;
        if (!(Epi::PAIRS && cur.alt == 0)) {
#pragma unroll
        for (int a = 0; a < 2; ++a)
#pragma unroll
            for (int b = 0; b < 2; ++b)
#pragma unroll
                for (int m = 0; m < 4; ++m)
#pragma unroll
                    for (int n = 0; n < 2; ++n) acc[a][b][m][n] = (f32x4){0.f, 0.f, 0.f, 0.f}; }
        cur = nxt; cA = nA; cB = nB; ++ui;
    }
    PG8_WAIT_V(0);
    if (wr == 0) PG8_BAR;
    PG8_BAR;
#undef PG8_SA
#undef PG8_SB
#undef PG8_STAGE
#undef PG8_LDA
#undef PG8_LDB
#undef PG8_MMA
#undef PG8_WAIT_V
#undef PG8_WAIT_L
#undef PG8_BAR
#undef PG8_SCHED
}
}
using pg8::Unit;
typedef f32x4 Acc[2][2][4][2];

__device__ __forceinline__ u32x4 pack8(const f32x4 a, const f32x4 b) { u32x4 w; w.x = cvt_pk_bf16(a[0], a[1]); w.y = cvt_pk_bf16(a[2], a[3]); w.z = cvt_pk_bf16(b[0], b[1]); w.w = cvt_pk_bf16(b[2], b[3]); return w; }
__device__ __forceinline__ void unpack8(const u32x4 w, f32x4& a, f32x4& b) { a = (f32x4){bflo(w.x), bfhi(w.x), bflo(w.y), bfhi(w.y)}; b = (f32x4){bflo(w.z), bfhi(w.z), bflo(w.w), bfhi(w.w)}; }
__device__ __forceinline__ f32x4 sig4(const f32x4 v) { return (f32x4){sigmoidf_(v[0]), sigmoidf_(v[1]), sigmoidf_(v[2]), sigmoidf_(v[3])}; }

__device__ __forceinline__ float row_rs(const float* ssq, int row) {
    const f32x4* q = (const f32x4*)(ssq + (size_t)row * 16); const f32x4 a = q[0], b = q[1], c = q[2], d = q[3];
    const float s = ((a[0] + a[1]) + (a[2] + a[3])) + ((b[0] + b[1]) + (b[2] + b[3])) + ((c[0] + c[1]) + (c[2] + c[3])) + ((d[0] + d[1]) + (d[2] + d[3]));
    return rsqrtf(s * (1.0f / DM) + EPS);
}
struct EpiStore {
    static constexpr bool PERM = true, HAS_PRE = true, PAIRS = false;
    bf16_t* O; int ldc; const float* rsv;
    __device__ __forceinline__ void pre(RsPre& r, const Unit& u, int wr, int fr) const {
#pragma unroll
        for (int ai = 0; ai < 2; ++ai)
#pragma unroll
            for (int m = 0; m < 4; ++m) r.rs[ai][m] = rsv[u.pm * 256 + wr * 64 + fr + ai * 128 + m * 16]; }
    __device__ __forceinline__ void operator()(const Acc& acc, const Unit& u, int wr, int wc, int fr, int fq, const RsPre& pr) const {
        asm volatile("" : "+v"(fr), "+v"(fq));
        const int row0 = u.pm * 256 + wr * 64 + fr, col0 = u.pn * 256 + wc * 32 + 8 * fq;
        const float (&rs)[2][4] = pr.rs;
#pragma unroll
        for (int ai = 0; ai < 2; ++ai)
#pragma unroll
            for (int m = 0; m < 4; ++m) { bf16_t* rowp = O + (size_t)(row0 + ai * 128 + m * 16) * ldc + col0;
#pragma unroll
                for (int bj = 0; bj < 2; ++bj) *(u32x4*)(rowp + bj * 128) = pack8(acc[ai][bj][m][0] * rs[ai][m], acc[ai][bj][m][1] * rs[ai][m]); }
    }
};
struct EpiGlu {
    static constexpr bool PERM = true, HAS_PRE = false, PAIRS = false;
    bf16_t* proj; const float* bias;
    __device__ __forceinline__ void operator()(const Acc& acc, const Unit& u, int wr, int wc, int fr, int fq) const {
        asm volatile("" : "+v"(fr), "+v"(fq));
        const int row0 = u.pm * 256 + wr * 64 + fr, col0 = u.pn * 256 + wc * 32 + 8 * fq;
        f32x4 bv[2][2];
#pragma unroll
        for (int bj = 0; bj < 2; ++bj)
#pragma unroll
            for (int n = 0; n < 2; ++n) bv[bj][n] = *(const f32x4*)(bias + col0 + bj * 128 + 4 * n);
#pragma unroll
        for (int ai = 0; ai < 2; ++ai) {
            u32x4 av[4][2];
#pragma unroll
            for (int m = 0; m < 4; ++m)
#pragma unroll
                for (int bj = 0; bj < 2; ++bj) av[m][bj] = *(const u32x4*)(proj + (size_t)(row0 + ai * 128 + m * 16) * NPROJ + col0 + bj * 128);
#pragma unroll
            for (int m = 0; m < 4; ++m) { bf16_t* rowp = proj + (size_t)(row0 + ai * 128 + m * 16) * NPROJ + col0;
#pragma unroll
                for (int bj = 0; bj < 2; ++bj) { f32x4 a0, a1; unpack8(av[m][bj], a0, a1);
                    const f32x4 o0 = a0 * sig4(acc[ai][bj][m][0] + bv[bj][0]), o1 = a1 * sig4(acc[ai][bj][m][1] + bv[bj][1]);
                    *(u32x4*)(rowp + C_GLU + bj * 128) = pack8(o0, o1); } } }
    }
};
template <int SECOND> struct EpiMix {
    static constexpr bool PERM = true, HAS_PRE = false, PAIRS = false;
    const bf16_t* gate; bf16_t* mixed;
    __device__ __forceinline__ void operator()(const Acc& acc, const Unit& u, int wr, int wc, int fr, int fq) const {
        asm volatile("" : "+v"(fr), "+v"(fq));
        const int row0 = u.pm * 256 + wr * 64 + fr, col0 = u.pn * 256 + wc * 32 + 8 * fq;
#pragma unroll
        for (int ai = 0; ai < 2; ++ai) {
            u32x4 gv[4][2], pv[4][2];
#pragma unroll
            for (int m = 0; m < 4; ++m)
#pragma unroll
                for (int bj = 0; bj < 2; ++bj) { const size_t row = (size_t)(row0 + ai * 128 + m * 16);
                    gv[m][bj] = *(const u32x4*)(gate + row * NPROJ + col0 + bj * 128);
                    if (SECOND) pv[m][bj] = *(const u32x4*)(mixed + row * 1024 + col0 + bj * 128); }
#pragma unroll
            for (int m = 0; m < 4; ++m) { const size_t row = (size_t)(row0 + ai * 128 + m * 16);
#pragma unroll
                for (int bj = 0; bj < 2; ++bj) { f32x4 g0, g1; unpack8(gv[m][bj], g0, g1);
                    f32x4 o0 = acc[ai][bj][m][0] * sig4(g0), o1 = acc[ai][bj][m][1] * sig4(g1);
                    if (SECOND) { f32x4 p0, p1; unpack8(pv[m][bj], p0, p1); o0 += p0; o1 += p1; }
                    *(u32x4*)(mixed + row * 1024 + col0 + bj * 128) = pack8(o0, o1); } } }
    }
};
struct EpiMixPair {
    static constexpr bool PERM = true, HAS_PRE = false, PAIRS = true;
    const bf16_t* ga; const bf16_t* gb; bf16_t* mixed;
    __device__ __forceinline__ void operator()(Acc& acc, const Unit& u, int wr, int wc, int fr, int fq) const {
        asm volatile("" : "+v"(fr), "+v"(fq));
        const int row0 = u.pm * 256 + wr * 64 + fr, col0 = u.pn * 256 + wc * 32 + 8 * fq;
#pragma unroll
        for (int ai = 0; ai < 2; ++ai) {
            u32x4 av[4][2], bv[4][2];
#pragma unroll
            for (int m = 0; m < 4; ++m)
#pragma unroll
                for (int bj = 0; bj < 2; ++bj) { const size_t off = (size_t)(row0 + ai * 128 + m * 16) * NPROJ + col0 + bj * 128;
                    bv[m][bj] = *(const u32x4*)(gb + off); if (u.alt == 0) av[m][bj] = *(const u32x4*)(ga + off); }
#pragma unroll
            for (int m = 0; m < 4; ++m)
#pragma unroll
                for (int bj = 0; bj < 2; ++bj) { f32x4 b0, b1; unpack8(bv[m][bj], b0, b1);
                    if (u.alt == 0) { f32x4 a0, a1; unpack8(av[m][bj], a0, a1);
#pragma unroll
                        for (int r = 0; r < 4; ++r) { acc[ai][bj][m][0][r] *= (1.0f + __expf(-b0[r])) * __builtin_amdgcn_rcpf(1.0f + __expf(-a0[r]));
                                                      acc[ai][bj][m][1][r] *= (1.0f + __expf(-b1[r])) * __builtin_amdgcn_rcpf(1.0f + __expf(-a1[r])); } }
                    else *(u32x4*)(mixed + (size_t)(row0 + ai * 128 + m * 16) * 1024 + col0 + bj * 128) = pack8(acc[ai][bj][m][0] * sig4(b0), acc[ai][bj][m][1] * sig4(b1)); } }
    }
};
struct EpiRes {
    static constexpr bool PERM = true, HAS_PRE = false, PAIRS = false;
    bf16_t* hb; float sc; float* part; float* ssq;
    __device__ __forceinline__ void operator()(const Acc& acc, const Unit& u, int wr, int wc, int fr, int fq) const {
        asm volatile("" : "+v"(fr), "+v"(fq));
        const int row0 = u.pm * 256 + wr * 64 + fr, col0 = u.pn * 256 + wc * 32 + 8 * fq;
        if (u.split) {
            float* pt = part + (size_t)(u.split - 1) * 256 * DM;
#pragma unroll
            for (int ai = 0; ai < 2; ++ai)
#pragma unroll
                for (int m = 0; m < 4; ++m)
#pragma unroll
                    for (int bj = 0; bj < 2; ++bj)
#pragma unroll
                        for (int n = 0; n < 2; ++n) *(f32x4*)(pt + (size_t)(wr * 64 + fr + ai * 128 + m * 16) * DM + col0 + bj * 128 + n * 4) = acc[ai][bj][m][n] * sc;
            return; }
#pragma unroll
        for (int ai = 0; ai < 2; ++ai) {
            u32x4 hv[4][2];
#pragma unroll
            for (int m = 0; m < 4; ++m)
#pragma unroll
                for (int bj = 0; bj < 2; ++bj) hv[m][bj] = *(const u32x4*)(hb + (size_t)(row0 + ai * 128 + m * 16) * DM + col0 + bj * 128);
#pragma unroll
            for (int m = 0; m < 4; ++m) { const size_t row = (size_t)(row0 + ai * 128 + m * 16); float sq = 0.f;
#pragma unroll
                for (int bj = 0; bj < 2; ++bj) { f32x4 o0, o1; unpack8(hv[m][bj], o0, o1); o0 += acc[ai][bj][m][0] * sc; o1 += acc[ai][bj][m][1] * sc;
                    *(u32x4*)(hb + row * DM + col0 + bj * 128) = pack8(o0, o1);
                    sq += ((o0[0] * o0[0] + o0[1] * o0[1]) + (o0[2] * o0[2] + o0[3] * o0[3])) + ((o1[0] * o1[0] + o1[1] * o1[1]) + (o1[2] * o1[2] + o1[3] * o1[3])); }
                const int lane = fq * 16 + fr; sq += shx(sq, lane, 16); sq += shx(sq, lane, 32);
                if (fq == 0) ssq[row * 16 + u.pn * 4 + wc] = sq; } }
    }
};
struct EpiFF {
    static constexpr bool PERM = true, HAS_PRE = true, PAIRS = false;
    bf16_t* ff; const float* rsv;
    __device__ __forceinline__ void pre(RsPre& r, const Unit& u, int wr, int fr) const {
#pragma unroll
        for (int ai = 0; ai < 2; ++ai)
#pragma unroll
            for (int m = 0; m < 4; ++m) r.rs[ai][m] = rsv[u.pm * 256 + wr * 64 + fr + ai * 128 + m * 16]; }
    __device__ __forceinline__ void operator()(const Acc& acc, const Unit& u, int wr, int wc, int fr, int fq, const RsPre& pr) const {
        asm volatile("" : "+v"(fr), "+v"(fq));
        const int row0 = u.pm * 256 + wr * 64 + fr, col0 = u.pn * 128 + wc * 32 + 8 * fq;
        const float (&rs)[2][4] = pr.rs;
#pragma unroll
        for (int ai = 0; ai < 2; ++ai)
#pragma unroll
            for (int m = 0; m < 4; ++m) { f32x4 o[2];
#pragma unroll
                for (int n = 0; n < 2; ++n) { const f32x4 a1 = acc[ai][0][m][n] * rs[ai][m], a3 = acc[ai][1][m][n] * rs[ai][m];
                    o[n] = (f32x4){siluf_(a1[0]) * a3[0], siluf_(a1[1]) * a3[1], siluf_(a1[2]) * a3[2], siluf_(a1[3]) * a3[3]}; }
                *(u32x4*)(ff + (size_t)(row0 + ai * 128 + m * 16) * DFF + col0) = pack8(o[0], o[1]); }
    }
};

__device__ __forceinline__ void conv_tile(const float* src, int ldsrc, int scol0, int k0, bf16_t* dst, int drow0, int K, float* lds, const float* ks = nullptr) {
    const int t = otid();
#pragma unroll
    for (int i = 0; i < 2; ++i) { const int r = (t >> 4) + 32 * i, c4 = (t & 15) * 4;
        const f32x4 v = *(const f32x4*)(src + (size_t)(k0 + r) * ldsrc + scol0 + c4);
        lds[r * 65 + c4 + 0] = v[0]; lds[r * 65 + c4 + 1] = v[1]; lds[r * 65 + c4 + 2] = v[2]; lds[r * 65 + c4 + 3] = v[3]; }
    __syncthreads();
    { const int n = t >> 3, kc = (t & 7) * 8; float v[8];
#pragma unroll
      for (int j = 0; j < 8; ++j) v[j] = lds[(kc + j) * 65 + n];
      if (ks) {
#pragma unroll
          for (int j = 0; j < 8; ++j) v[j] *= ks[k0 + kc + j]; }
      u32x4 w; w.x = cvt_pk_bf16(v[0], v[1]); w.y = cvt_pk_bf16(v[2], v[3]); w.z = cvt_pk_bf16(v[4], v[5]); w.w = cvt_pk_bf16(v[6], v[7]);
      *(u32x4*)(dst + (size_t)(drow0 + n) * K + k0 + kc) = w; }
    __syncthreads();
}
struct Sub4 { int scol[4], drow[4]; };
__device__ __forceinline__ void conv_tile4(const float* src, int ldsrc, const Sub4& sb, int k0, bf16_t* dst, int K, float* lds, const float* ks) {
    const int t = otid(); f32x4 v[4][2];
#pragma unroll
    for (int j = 0; j < 4; ++j)
#pragma unroll
        for (int i = 0; i < 2; ++i) v[j][i] = *(const f32x4*)(src + (size_t)(k0 + (t >> 4) + 32 * i) * ldsrc + sb.scol[j] + (t & 15) * 4);
    __syncthreads();
#pragma unroll
    for (int j = 0; j < 4; ++j)
#pragma unroll
        for (int i = 0; i < 2; ++i) { float* q = lds + j * 4160 + ((t >> 4) + 32 * i) * 65 + (t & 15) * 4; q[0] = v[j][i][0]; q[1] = v[j][i][1]; q[2] = v[j][i][2]; q[3] = v[j][i][3]; }
    __syncthreads();
    const int n = t >> 3, kc = (t & 7) * 8; float sc[8];
#pragma unroll
    for (int e = 0; e < 8; ++e) sc[e] = ks ? ks[k0 + kc + e] : 1.0f;
#pragma unroll
    for (int j = 0; j < 4; ++j) { float x[8];
#pragma unroll
        for (int e = 0; e < 8; ++e) x[e] = lds[j * 4160 + (kc + e) * 65 + n] * sc[e];
        u32x4 w; w.x = cvt_pk_bf16(x[0], x[1]); w.y = cvt_pk_bf16(x[2], x[3]); w.z = cvt_pk_bf16(x[4], x[5]); w.w = cvt_pk_bf16(x[6], x[7]);
        *(u32x4*)(dst + (size_t)(sb.drow[j] + n) * K + k0 + kc) = w; }
}
constexpr int NCONV_MIX = 256 + 64 + 16 + 32 + 32 + 64;
__device__ void conv_mixer_item(const Params& p, int l, int it, float* lds) {
    bf16_t* W = (bf16_t*)(p.ws + WS_W); Sub4 sb;
    if (it < 256) { const int kt = it & 15, nb = it >> 4;
#pragma unroll
        for (int j = 0; j < 4; ++j) { const int mycol = (nb < 8 ? nb * 256 : 2304 + (nb - 8) * 256) + j * 64; sb.drow[j] = mycol; sb.scol[j] = nb < 8 ? mycol : mycol - 240; }
        conv_tile4(p.w_in + (size_t)l * 1024 * 4112, 4112, sb, kt * 64, W + W_IN, 1024, lds, p.norm1 + (size_t)l * DM); return; }
    it -= 256;
    if (it < 64) {
        const int kb = it & 1, jb = it >> 1, k = kb * 512 + otid();
        const float* src = p.w_in + (size_t)l * 1024 * 4112 + (size_t)k * 4112 + 2048; float a[16];
#pragma unroll
        for (int q = 0; q < 4; ++q) { const f32x4 v = *(const f32x4*)(src + 4 * q); a[4 * q] = v[0]; a[4 * q + 1] = v[1]; a[4 * q + 2] = v[2]; a[4 * q + 3] = v[3]; }
        const float* wa = p.w_alpha + (size_t)l * 16 * 256; const float g1 = p.norm1[(size_t)l * DM + k];
        for (int jj = 0; jj < 8; ++jj) { const int j = jb * 8 + jj; float s = 0.f;
#pragma unroll
            for (int r = 0; r < 16; ++r) s += a[r] * wa[r * 256 + j];
            W[W_IN + (size_t)(C_GL + j) * 1024 + k] = f2bf(s * g1); }
        return; }
    it -= 64;
    const float* src; int ld, kt, nb, K; size_t wo;
    if (it < 16) { src = p.w_glu + (size_t)l * 512 * 512; ld = 512; kt = it & 7; nb = it >> 3; K = 512; wo = W_GLU; }
    else if ((it -= 16) < 32) { src = p.w_pa + (size_t)l * 512 * 1024; ld = 1024; kt = it & 7; nb = it >> 3; K = 512; wo = W_PA; }
    else if ((it -= 32) < 32) { src = p.w_pb + (size_t)l * 512 * 1024; ld = 1024; kt = it & 7; nb = it >> 3; K = 512; wo = W_PB; }
    else { it -= 32; src = p.w_out + (size_t)l * 1024 * 1024; ld = 1024; kt = it & 15; nb = it >> 4; K = 1024; wo = W_OUT; }
#pragma unroll
    for (int j = 0; j < 4; ++j) { sb.scol[j] = nb * 256 + j * 64; sb.drow[j] = nb * 256 + j * 64; }
    conv_tile4(src, ld, sb, kt * 64, W + wo, K, lds, nullptr);
}
constexpr int NCONV_FF = 3 * 176;
__device__ void conv_ff_item(const Params& p, int l, int it, float* lds) {
    bf16_t* W = (bf16_t*)(p.ws + WS_W); Sub4 sb;
    if (it < 352) { const int which = it >= 176; if (which) it -= 176;
        const int kt = it & 15, nb = it >> 4;
        const float* src = (which ? p.w_ff3 : p.w_ff1) + (size_t)l * 1024 * DFF;
#pragma unroll
        for (int j = 0; j < 4; ++j) { const int n0 = nb * 256 + j * 64; sb.scol[j] = n0; sb.drow[j] = (n0 >> 7) * 256 + (n0 & 127) + which * 128; }
        conv_tile4(src, DFF, sb, kt * 64, W + W_FF13, 1024, lds, p.norm2 + (size_t)l * DM); return; }
    it -= 352;
    { const int nb = it & 3, kt = it >> 2;
#pragma unroll
      for (int j = 0; j < 4; ++j) { sb.scol[j] = nb * 256 + j * 64; sb.drow[j] = nb * 256 + j * 64; }
      conv_tile4(p.w_ff2 + (size_t)l * DFF * 1024, 1024, sb, kt * 64, W + W_FF2, DFF, lds, nullptr); }
}

__device__ __forceinline__ void sincos_small(float x, float& sn, float& cs) {
    const float k = rintf(x * 0.636619772f);
    float r = fmaf(-k, 1.5703125f, x); r = fmaf(-k, 4.837512969970703125e-4f, r); r = fmaf(-k, 7.54978995489188216e-8f, r);
    const int q = ((int)k) & 3; const float r2 = r * r;
    const float sp = r + r * r2 * (-1.6666654611e-1f + r2 * (8.3321608736e-3f + r2 * (-1.9515295891e-4f)));
    const float cp = 1.0f - 0.5f * r2 + r2 * r2 * (4.166664568298827e-2f + r2 * (-1.388731625493765e-3f + r2 * 2.443315711809948e-5f));
    sn = (q == 0) ? sp : (q == 1) ? cp : (q == 2) ? -sp : -cp;
    cs = (q == 0) ? cp : (q == 1) ? -sp : (q == 2) ? -cp : sp;
}
__device__ void s5_prep_item(const Params& p, int l, int gi, float* lds) {
    const int g = gi >> 3, part = gi & 7;
    __syncthreads();
    float* ap_re = lds;
    float* ap_im = ap_re + 17 * 64;
    float* bb_re = ap_im + 17 * 64;
    float* bb_im = bb_re + 1024;
    float* cc_re = bb_im + 1024;
    float* cc_im = cc_re + 1024;
    float* Kd = cc_im + 1024;
    const int t = otid();
    const size_t lg = (size_t)l * 32 + g;
    if (t < 64) { const int pp = t;
        const float step = expf(p.log_step[lg]);
        const float lr = fminf(p.lam_re[lg * 64 + pp], -1e-4f), li = p.lam_im[lg * 64 + pp];
        const float mag = expf(lr * step); float sn, cs; sincos_small(li * step, sn, cs);
        const float abr = mag * cs, abi = mag * sn;
        float pr = 1.f, pi = 0.f;
        for (int d = 0; d <= 16; ++d) { ap_re[d * 64 + pp] = pr; ap_im[d * 64 + pp] = pi; const float nr_ = pr * abr - pi * abi, ni_ = pr * abi + pi * abr; pr = nr_; pi = ni_; }
        const float den = lr * lr + li * li, nr = abr - 1.0f, cr = (nr * lr + abi * li) / den, ci = (abi * lr - nr * li) / den;
        for (int h = 0; h < 16; ++h) { const float br = p.b_re[(lg * 64 + pp) * 16 + h], bi = p.b_im[(lg * 64 + pp) * 16 + h];
            bb_re[pp * 16 + h] = cr * br - ci * bi; bb_im[pp * 16 + h] = cr * bi + ci * br; }
        if (part == 0) { float* a16 = (float*)(p.ws + WS_A16) + (g * 64 + pp) * 2; a16[0] = ap_re[16 * 64 + pp]; a16[1] = ap_im[16 * 64 + pp]; }
    }
    for (int i = t; i < 1024; i += 512) { cc_re[i] = p.c_re[lg * 1024 + i]; cc_im[i] = p.c_im[lg * 1024 + i]; }
    __syncthreads();
    for (int i3 = t; i3 < 768; i3 += 512) { const int d = 2 * part - 1 + (i3 >> 8); if (d < 0) continue;
        const int idx = (d << 8) + (i3 & 255), h = (idx >> 4) & 15, h2 = idx & 15; float s = 0.f;
        for (int pp = 0; pp < 64; ++pp) { const float cr = cc_re[h * 64 + pp], ci = cc_im[h * 64 + pp], ar = ap_re[d * 64 + pp], ai = ap_im[d * 64 + pp];
            const float gr = cr * ar - ci * ai, gi = cr * ai + ci * ar; s += gr * bb_re[pp * 16 + h2] - gi * bb_im[pp * 16 + h2]; }
        Kd[idx] = s; }
    __syncthreads();
    bf16_t* Wy = (bf16_t*)(p.ws + WS_WY) + (size_t)g * 256 * 384;
    for (int i2 = part * 4096 + t; i2 < (part + 1) * 4096; i2 += 512) { const int n = i2 >> 7, kk = i2 & 127, j = n >> 4, h = n & 15, pp = kk & 63, im = kk >> 6;
        const float cr = cc_re[h * 64 + pp], ci = cc_im[h * 64 + pp], ar = ap_re[(j + 1) * 64 + pp], ai = ap_im[(j + 1) * 64 + pp];
        Wy[(size_t)n * 384 + 256 + kk] = f2bf(im ? -(cr * ai + ci * ar) : (cr * ar - ci * ai)); }
    bf16_t* Tz = (bf16_t*)(p.ws + WS_TZ) + (size_t)g * 16 * 512;
    for (int idx = part * 1024 + t; idx < (part + 1) * 1024; idx += 512) { const int d = idx >> 9, h = (idx >> 5) & 15, kk = idx & 31, sl = kk >> 4, h2 = kk & 15, lag = d - sl;
        Tz[idx] = f2bf(lag >= 0 ? Kd[(lag << 8) + (h << 4) + h2] : 0.f); }
    bf16_t* We = (bf16_t*)(p.ws + WS_WE) + (size_t)g * 128 * 256;
    for (int idx = part * 4096 + t; idx < (part + 1) * 4096; idx += 512) { const int n = idx >> 8, k = idx & 255, pp = n & 63, im = n >> 6, s = k >> 4, h2 = k & 15;
        const float ar = ap_re[(15 - s) * 64 + pp], ai = ap_im[(15 - s) * 64 + pp], br = bb_re[pp * 16 + h2], bi = bb_im[pp * 16 + h2];
        We[idx] = f2bf(im ? (ar * bi + ai * br) : (ar * br - ai * bi)); }
    __syncthreads();
}

__device__ __forceinline__ float wave_sum(float v, int lane) {
#pragma unroll
    for (int o = 32; o >= 1; o >>= 1) v += shx(v, lane, o);
    return v;
}
__device__ void rmsnorm_rows(const Params& p, float* h, const float* gain, bf16_t* z, int nslice) {
    const int t_ = otid(), wave = t_ >> 6, lane = t_ & 63;
    f32x4 gv[4];
#pragma unroll
    for (int i = 0; i < 4; ++i) gv[i] = *(const f32x4*)(gain + lane * 4 + 256 * i);
    for (int row0 = p.bid * 16 + wave * 2; row0 < MP; row0 += p.nblk * 16) {
        f32x4 v[2][4];
#pragma unroll
        for (int rr = 0; rr < 2; ++rr)
#pragma unroll
            for (int i = 0; i < 4; ++i) v[rr][i] = *(const f32x4*)(h + (size_t)(row0 + rr) * DM + lane * 4 + 256 * i);
#pragma unroll
        for (int rr = 0; rr < 2; ++rr) { const int row = row0 + rr; float* hp = h + (size_t)row * DM; float ss = 0.f;
            if (row >= MP - 256 && nslice > 0) {
                const float* pt = (const float*)(p.ws + WS_PART) + (size_t)(row - (MP - 256)) * DM + lane * 4;
                for (int sl = 0; sl < nslice; ++sl)
#pragma unroll
                    for (int i = 0; i < 4; ++i) v[rr][i] += *(const f32x4*)(pt + (size_t)sl * 256 * DM + 256 * i);
#pragma unroll
                for (int i = 0; i < 4; ++i) *(f32x4*)(hp + lane * 4 + 256 * i) = v[rr][i]; }
#pragma unroll
            for (int i = 0; i < 4; ++i) ss += v[rr][i][0] * v[rr][i][0] + v[rr][i][1] * v[rr][i][1] + v[rr][i][2] * v[rr][i][2] + v[rr][i][3] * v[rr][i][3];
            ss = wave_sum(ss, lane); const float rs = rsqrtf(ss * (1.0f / DM) + EPS);
#pragma unroll
            for (int i = 0; i < 4; ++i) { const f32x4 o = v[rr][i] * rs * gv[i]; u32x2 w; w.x = cvt_pk_bf16(o[0], o[1]); w.y = cvt_pk_bf16(o[2], o[3]);
                *(u32x2*)(z + (size_t)row * DM + lane * 4 + 256 * i) = w; } }
    }
}
__device__ void final_norm(const Params& p, const bf16_t* hb, const float* gain, float* out) {
    const int t_ = otid(), wave = t_ >> 6, lane = t_ & 63;
    f32x4 gv[4];
#pragma unroll
    for (int i = 0; i < 4; ++i) gv[i] = *(const f32x4*)(gain + lane * 4 + 256 * i);
    for (int orow = p.bid * 8 + wave; orow < NBATCH * SEQ; orow += p.nblk * 8) {
        const int b = orow >> 12, tt = orow & 4095, row = b * TB + NMETA + tt; const bf16_t* hp = hb + (size_t)row * DM; f32x4 v[4]; float ss = 0.f;
#pragma unroll
        for (int i = 0; i < 4; ++i) { const u32x2 w = *(const u32x2*)(hp + lane * 4 + 256 * i); v[i] = (f32x4){bflo(w.x), bfhi(w.x), bflo(w.y), bfhi(w.y)}; }
        if (row >= MP - 256) { const float* pt = (const float*)(p.ws + WS_PART) + (size_t)(row - (MP - 256)) * DM + lane * 4;
            for (int sl = 0; sl < 11; ++sl)
#pragma unroll
                for (int i = 0; i < 4; ++i) v[i] += *(const f32x4*)(pt + (size_t)sl * 256 * DM + 256 * i); }
#pragma unroll
        for (int i = 0; i < 4; ++i) ss += v[i][0] * v[i][0] + v[i][1] * v[i][1] + v[i][2] * v[i][2] + v[i][3] * v[i][3];
        ss = wave_sum(ss, lane); const float rs = rsqrtf(ss * (1.0f / DM) + EPS);
#pragma unroll
        for (int i = 0; i < 4; ++i) *(f32x4*)(out + (size_t)orow * DM + lane * 4 + 256 * i) = v[i] * rs * gv[i];
    }
}
__device__ void init_h(const Params& p) {
    bf16_t* hb = (bf16_t*)(p.ws + WS_H);
    const int t_ = otid(), wave = t_ >> 6, lane = t_ & 63;
    for (int row = p.bid * 8 + wave; row < MP; row += p.nblk * 8) {
        const int b = row / TB, r = row - b * TB; f32x4 v[4]; float ss = 0.f;
#pragma unroll
        for (int i = 0; i < 4; ++i) { const int c4 = lane * 4 + 256 * i; v[i] = (f32x4){0.f, 0.f, 0.f, 0.f};
            if (r < NMETA) v[i] = *(const f32x4*)(p.meta + (size_t)r * DM + c4);
            else if (r < NMETA + SEQ) v[i] = *(const f32x4*)(p.x + ((size_t)b * SEQ + (r - NMETA)) * DM + c4);
            u32x2 w; w.x = cvt_pk_bf16(v[i][0], v[i][1]); w.y = cvt_pk_bf16(v[i][2], v[i][3]); *(u32x2*)(hb + (size_t)row * DM + c4) = w;
            ss += v[i][0] * v[i][0] + v[i][1] * v[i][1] + v[i][2] * v[i][2] + v[i][3] * v[i][3]; }
        ss = wave_sum(ss, lane);
        if (lane == 0) ((float*)(p.ws + WS_RS1))[row] = rsqrtf(ss * (1.0f / DM) + EPS);
    }
}
__device__ void fold_rows(const Params& p, int nslice, const float* ssq, float* rsv) {
    bf16_t* hb = (bf16_t*)(p.ws + WS_H);
    const int t_ = otid(), wave = t_ >> 6, lane = t_ & 63;
    for (int idx = p.bid * 8 + wave; idx < 256; idx += p.nblk * 8) {
        const int row = MP - 256 + idx; bf16_t* hp = hb + (size_t)row * DM; f32x4 v[4]; float ss = 0.f;
#pragma unroll
        for (int i = 0; i < 4; ++i) { const u32x2 w = *(const u32x2*)(hp + lane * 4 + 256 * i); v[i] = (f32x4){bflo(w.x), bfhi(w.x), bflo(w.y), bfhi(w.y)}; }
        const float* pt = (const float*)(p.ws + WS_PART) + (size_t)idx * DM + lane * 4;
        for (int s0 = 0; s0 < nslice; s0 += 4) {
            f32x4 tq[4][4];
#pragma unroll
            for (int q = 0; q < 4; ++q) { const int sl = s0 + q < nslice ? s0 + q : nslice - 1;
#pragma unroll
                for (int i = 0; i < 4; ++i) tq[q][i] = *(const f32x4*)(pt + (size_t)sl * 256 * DM + 256 * i); }
#pragma unroll
            for (int q = 0; q < 4; ++q) { const float on = s0 + q < nslice ? 1.f : 0.f;
#pragma unroll
                for (int i = 0; i < 4; ++i) v[i] += tq[q][i] * on; } }
#pragma unroll
        for (int i = 0; i < 4; ++i) { u32x2 w; w.x = cvt_pk_bf16(v[i][0], v[i][1]); w.y = cvt_pk_bf16(v[i][2], v[i][3]); *(u32x2*)(hp + lane * 4 + 256 * i) = w;
            ss += v[i][0] * v[i][0] + v[i][1] * v[i][1] + v[i][2] * v[i][2] + v[i][3] * v[i][3]; }
        ss = wave_sum(ss, lane);
        if (lane == 0) rsv[row] = rsqrtf(ss * (1.0f / DM) + EPS);
    }
    for (int row = p.bid * 512 + t_; row < MP - 256; row += p.nblk * 512) rsv[row] = row_rs(ssq, row);
}

constexpr int S5_ITEMS = 512;
__device__ void s5a_item(const Params& p, int item, LAS unsigned char* lds) {
    const int xcd_ = item & 7, slot_ = (item >> 3) & 31, g = xcd_ * 4 + (slot_ & 3), span = (item >> 8) * 8 + (slot_ >> 2), mt0 = span * 8, nmt = span == 15 ? 9 : 8;
    const int t = otid(), wave = t >> 6, lane = t & 63, fr = lane & 15, fq = lane >> 4;
    const bf16_t* proj = (const bf16_t*)(p.ws + WS_PROJ);
    const bf16_t* We = (const bf16_t*)(p.ws + WS_WE) + (size_t)g * 128 * 256;
    float* Xloc = (float*)(p.ws + WS_XLOC);
    u32x4 wf[8];
#pragma unroll
    for (int q = 0; q < 8; ++q) { const int i = t + 512 * q, r = i >> 5, c = i & 31; wf[q] = *(const u32x4*)(We + r * 256 + c * 8); }
    bf16x8 a[8];
    { const int mt = mt0 + wave;
#pragma unroll
      for (int ks = 0; ks < 8; ++ks) a[ks] = *(const bf16x8*)(proj + (size_t)((mt * 16 + fr) * 16 + 2 * ks + (fq >> 1)) * NPROJ + C_U + g * 16 + (fq & 1) * 8); }
    __syncthreads();
#pragma unroll
    for (int q = 0; q < 8; ++q) { const int i = t + 512 * q, r = i >> 5, c = i & 31; *(LAS u32x4*)(lds + r * 528 + c * 16) = wf[q]; }
    __syncthreads();
    for (int mt = mt0 + wave; mt < mt0 + nmt; mt += 8) {
        if (mt != mt0 + wave) {
#pragma unroll
            for (int ks = 0; ks < 8; ++ks) a[ks] = *(const bf16x8*)(proj + (size_t)((mt * 16 + fr) * 16 + 2 * ks + (fq >> 1)) * NPROJ + C_U + g * 16 + (fq & 1) * 8); }
#pragma unroll 1
        for (int nt = 0; nt < 8; ++nt) { f32x4 acc = (f32x4){0.f, 0.f, 0.f, 0.f};
#pragma unroll
            for (int ks = 0; ks < 8; ++ks) { const bf16x8 b = *(const LAS bf16x8*)(lds + (nt * 16 + fr) * 528 + (ks * 32 + fq * 8) * 2); acc = mfma16(b, a[ks], acc); }
            *(f32x4*)(Xloc + ((size_t)(mt * 16 + fr) * 32 + g) * 128 + nt * 16 + 4 * fq) = acc; }
    }
}
__device__ void s5_scan(const Params& p) {
    const int lane = otid() & 63;
    float* Xloc = (float*)(p.ws + WS_XLOC);
    const float* a16 = (const float*)(p.ws + WS_A16);
    for (int ci = p.bid; ci < 256; ci += p.nblk) {
        const int b = ci >> 5, g = ci & 31;
        const float ar = a16[(g * 64 + lane) * 2], ai = a16[(g * 64 + lane) * 2 + 1];
        float* base = Xloc + ((size_t)(b * 258) * 32 + g) * 128 + lane;
        float sr = 0.f, si = 0.f;
        float xr[43], xi[43];
#pragma unroll
        for (int j = 0; j < 43; ++j) { xr[j] = base[(size_t)j * 4096]; xi[j] = base[(size_t)j * 4096 + 64]; }
        for (int c0 = 0; c0 < 258; c0 += 43) { float yr[43], yi[43]; const int cn = c0 + 43 < 258 ? c0 + 43 : c0;
#pragma unroll
            for (int j = 0; j < 43; ++j) { yr[j] = base[(size_t)(cn + j) * 4096]; yi[j] = base[(size_t)(cn + j) * 4096 + 64]; }
#pragma unroll
            for (int j = 0; j < 43; ++j) { if (!p.dry) { base[(size_t)(c0 + j) * 4096] = sr; base[(size_t)(c0 + j) * 4096 + 64] = si; }
                const float nr = ar * sr - ai * si + xr[j], ni = ar * si + ai * sr + xi[j]; sr = nr; si = ni; }
#pragma unroll
            for (int j = 0; j < 43; ++j) { xr[j] = yr[j]; xi[j] = yi[j]; } }
    }
}
__device__ void s5c_item(const Params& p, int l, int item, LAS unsigned char* lds) {
    const int xcd_ = item & 7, slot_ = (item >> 3) & 31, g = xcd_ * 4 + (slot_ & 3), span = (item >> 8) * 8 + (slot_ >> 2), mt0 = span * 8, nmt = span == 15 ? 9 : 8, iters = (nmt + 7) >> 3;
    const int t = otid(), wave = t >> 6, lane = t & 63, fr = lane & 15, fq = lane >> 4;
    bf16_t* proj = (bf16_t*)(p.ws + WS_PROJ);
    const bf16_t* Wy = (const bf16_t*)(p.ws + WS_WY) + (size_t)g * 256 * 384;
    const bf16_t* Tz = (const bf16_t*)(p.ws + WS_TZ) + (size_t)g * 16 * 512;
    const float* Xin = (const float*)(p.ws + WS_XLOC);
    const f32x4 dsk = *(const f32x4*)(p.d_skip + (size_t)l * 512 + g * 16 + 4 * fq);
    for (int it = 0; it < iters; ++it) {
        const int mt = mt0 + it * 8 + wave; const bool active = mt < mt0 + nmt;
        u32x4 omf[8];
#pragma unroll
        for (int q = 0; q < 8; ++q) { const int i = t + 512 * q, r = i >> 4, c = i & 15; omf[q] = *(const u32x4*)(Wy + (size_t)r * 384 + 256 + c * 8); }
        bf16x8 tf[16];
#pragma unroll
        for (int d = 0; d < 16; ++d) tf[d] = *(const bf16x8*)(Tz + d * 512 + fr * 32 + fq * 8);
        bf16x8 a[12];
        if (active) {
#pragma unroll
            for (int ks = 0; ks < 8; ++ks) a[ks] = *(const bf16x8*)(proj + (size_t)((mt * 16 + fr) * 16 + 2 * ks + (fq >> 1)) * NPROJ + C_U + g * 16 + (fq & 1) * 8);
#pragma unroll
            for (int kk = 0; kk < 4; ++kk) { const float* xp = Xin + ((size_t)(mt * 16 + fr) * 32 + g) * 128 + kk * 32 + fq * 8; const f32x4 x0 = *(const f32x4*)xp, x1 = *(const f32x4*)(xp + 4);
                const u32x4 w = pack8(x0, x1); a[8 + kk] = *(const bf16x8*)&w; }
        } else {
#pragma unroll
            for (int ks = 0; ks < 12; ++ks) a[ks] = (bf16x8){0, 0, 0, 0, 0, 0, 0, 0};
        }
        __syncthreads();
#pragma unroll
        for (int q = 0; q < 8; ++q) { const int i = t + 512 * q, r = i >> 4, c = i & 15; *(LAS u32x4*)(lds + r * 272 + c * 16) = omf[q]; }
        u32x2 uwv[16];
        if (active) {
#pragma unroll
            for (int j = 0; j < 16; ++j) uwv[j] = *(const u32x2*)(proj + (size_t)((mt * 16 + fr) * 16 + j) * NPROJ + C_U + g * 16 + 4 * fq);
        } else {
#pragma unroll
            for (int j = 0; j < 16; ++j) uwv[j] = (u32x2){0u, 0u};
        }
        __syncthreads();
        if (active) {
#pragma unroll
            for (int j = 0; j < 16; ++j) { f32x4 acc = (f32x4){0.f, 0.f, 0.f, 0.f};
#pragma unroll
                for (int ks = 0; ks < 8; ++ks) if (ks <= (j >> 1)) acc = mfma16(tf[j - 2 * ks], a[ks], acc);
#pragma unroll
                for (int kk = 0; kk < 4; ++kk) { const bf16x8 b = *(const LAS bf16x8*)(lds + (j * 16 + fr) * 272 + (kk * 32 + fq * 8) * 2); acc = mfma16(b, a[8 + kk], acc); }
                bf16_t* up = proj + (size_t)((mt * 16 + fr) * 16 + j) * NPROJ + C_U + g * 16 + 4 * fq;
                const u32x2 uw = uwv[j];
                const float y0 = acc[0] + dsk[0] * bflo(uw.x), y1 = acc[1] + dsk[1] * bfhi(uw.x), y2 = acc[2] + dsk[2] * bflo(uw.y), y3 = acc[3] + dsk[3] * bfhi(uw.y);
                u32x2 ow; ow.x = cvt_pk_bf16(gelu_tanh(y0), gelu_tanh(y1)); ow.y = cvt_pk_bf16(gelu_tanh(y2), gelu_tanh(y3));
                if (!p.dry) *(u32x2*)up = ow;
                __builtin_amdgcn_sched_barrier(0); }
        }
    }
}

constexpr int GLA_ITEMS = NBATCH * 4 * (GCH / 2);
constexpr int GL_QD = 0, GL_KI = 9216, GL_P = 18432, GL_VT = 27648, GL_SEG = 46080, GL_HALF = 47104;
struct GlaLoads { unsigned short xl[16], xk[16], xq[16], vv[4][8]; };
__device__ __forceinline__ void gla_issue_loads(GlaLoads& L, const bf16_t* proj, int b, int h, int n, int dk, int seg, int t4, bool want_q) {
#pragma unroll
    for (int i = 0; i < 16; ++i) { const int rb = n * 64 + seg * 16 + i, rc = rb < TB ? rb : TB - 1; const bf16_t* rp = proj + (size_t)(b * TB + rc) * NPROJ + h * 64 + dk;
        L.xl[i] = rp[C_GL]; L.xk[i] = rp[C_K]; if (want_q) L.xq[i] = rp[C_Q]; }
#pragma unroll
    for (int q = 0; q < 4; ++q) { const int task = t4 + 256 * q, dv = task & 127, rg = task >> 7;
#pragma unroll
        for (int j = 0; j < 8; ++j) { const int rb = n * 64 + rg * 8 + j, rc = rb < TB ? rb : TB - 1; L.vv[q][j] = proj[(size_t)(b * TB + rc) * NPROJ + C_V + h * 128 + dv]; } }
}
__device__ __forceinline__ float gla_cumsum(const Params& p, int l, const GlaLoads& L, int h, int n, int dk, int seg, LAS unsigned char* hl, float (&bc)[16]) {
    const float ba = p.b_alpha[(size_t)l * 256 + h * 64 + dk]; float run = 0.f;
#pragma unroll
    for (int i = 0; i < 16; ++i) { const int rb = n * 64 + seg * 16 + i; const float la = rb < TB ? logsigmoidf_(bf2f(L.xl[i]) + ba) * (1.0f / 16.0f) : 0.f;
        run += la; bc[i] = run; }
    LAS float* segs = (LAS float*)(hl + GL_SEG);
    segs[seg * 64 + dk] = run;
    __syncthreads();
    float pre = 0.f, tot = 0.f;
#pragma unroll
    for (int s = 0; s < 4; ++s) { const float v = segs[s * 64 + dk]; tot += v; if (s < seg) pre += v; }
#pragma unroll
    for (int i = 0; i < 16; ++i) bc[i] += pre;
    return tot;
}
__device__ __forceinline__ void gla_store_vT(const GlaLoads& L, int n, int t4, LAS unsigned char* hl) {
#pragma unroll
    for (int q = 0; q < 4; ++q) { const int task = t4 + 256 * q, dv = task & 127, rg = task >> 7; unsigned v[8];
#pragma unroll
        for (int j = 0; j < 8; ++j) { const int rb = n * 64 + rg * 8 + j; v[j] = rb < TB ? (unsigned)L.vv[q][j] : 0u; }
        u32x4 w; w.x = v[0] | (v[1] << 16); w.y = v[2] | (v[3] << 16); w.z = v[4] | (v[5] << 16); w.w = v[6] | (v[7] << 16);
        *(LAS u32x4*)(hl + GL_VT + dv * 144 + rg * 16) = w; }
}
__device__ void gla1_item(const Params& p, int l, int item, LAS unsigned char* lds) {
    const int t = otid(), half = t >> 8, t4 = t & 255, wv = (t >> 6) & 3, lane = t & 63, fr = lane & 15, fq = lane >> 4;
    const int pair = item % (GCH / 2), bh = item / (GCH / 2), b = bh >> 2, h = bh & 3, n = pair * 2 + half;
    const bf16_t* proj = (const bf16_t*)(p.ws + WS_PROJ);
    LAS unsigned char* hl = lds + half * GL_HALF;
    const int dk = t4 & 63, seg = t4 >> 6;
    GlaLoads L; gla_issue_loads(L, proj, b, h, n, dk, seg, t4, false);
    __syncthreads();
    float bc[16];
    const float tot = gla_cumsum(p, l, L, h, n, dk, seg, hl, bc);
    { unsigned w[8];
#pragma unroll
      for (int i = 0; i < 16; i += 2) { const int rb = n * 64 + seg * 16 + i;
          const float k0 = rb < TB ? bf2f(L.xk[i]) * __expf(tot - bc[i]) : 0.f, k1 = rb + 1 < TB ? bf2f(L.xk[i + 1]) * __expf(tot - bc[i + 1]) : 0.f;
          w[i >> 1] = cvt_pk_bf16(k0, k1); }
      *(LAS u32x4*)(hl + GL_KI + dk * 144 + seg * 32) = (u32x4){w[0], w[1], w[2], w[3]};
      *(LAS u32x4*)(hl + GL_KI + dk * 144 + seg * 32 + 16) = (u32x4){w[4], w[5], w[6], w[7]}; }
    gla_store_vT(L, n, t4, hl);
    if (seg == 0) ((float*)(p.ws + WS_DECAY))[((size_t)bh * GCH + n) * 64 + dk] = __expf(tot);
    __syncthreads();
    bf16_t* kvT = (bf16_t*)((unsigned char*)p.out + OS_KVT) + ((size_t)bh * GCH + n) * 8192;
#pragma unroll
    for (int mt = 0; mt < 2; ++mt) { const int dv0 = wv * 32 + mt * 16;
        bf16x8 rf[2];
#pragma unroll
        for (int ks = 0; ks < 2; ++ks) rf[ks] = *(const LAS bf16x8*)(hl + GL_VT + (dv0 + fr) * 144 + (ks * 32 + fq * 8) * 2);
#pragma unroll
        for (int nt = 0; nt < 4; ++nt) { f32x4 acc = (f32x4){0.f, 0.f, 0.f, 0.f};
#pragma unroll
            for (int ks = 0; ks < 2; ++ks) { const bf16x8 cf = *(const LAS bf16x8*)(hl + GL_KI + (nt * 16 + fr) * 144 + (ks * 32 + fq * 8) * 2); acc = mfma16(cf, rf[ks], acc); }
            u32x2 w; w.x = cvt_pk_bf16(acc[0], acc[1]); w.y = cvt_pk_bf16(acc[2], acc[3]);
            *(u32x2*)(kvT + (dv0 + fr) * 64 + nt * 16 + 4 * fq) = w; } }
}
__device__ void gla_scan(const Params& p) {
    const int tt = otid() - 64;
    if (tt < 0 || tt >= 256) return;
    bf16_t* kvT = (bf16_t*)((unsigned char*)p.out + OS_KVT);
    const float* decay = (const float*)(p.ws + WS_DECAY);
    for (int blk = p.bid; blk < 256; blk += p.nblk) {
        const int qi = blk * 256 + tt, bh = qi >> 11, rem = qi & 2047, dv = rem >> 4, dkq = rem & 15;
        bf16_t* kp = kvT + (size_t)bh * GCH * 8192 + dv * 64 + dkq * 4; const float* dp = decay + (size_t)bh * GCH * 64 + dkq * 4;
        f32x4 S = (f32x4){0.f, 0.f, 0.f, 0.f};
        for (int n0 = 0; n0 < 65; n0 += 13) { u32x2 w[13]; f32x4 d[13];
#pragma unroll
            for (int j = 0; j < 13; ++j) { w[j] = *(const u32x2*)(kp + (size_t)(n0 + j) * 8192); d[j] = *(const f32x4*)(dp + (n0 + j) * 64); }
#pragma unroll
            for (int j = 0; j < 13; ++j) { u32x2 o; o.x = cvt_pk_bf16(S[0], S[1]); o.y = cvt_pk_bf16(S[2], S[3]); if (!p.dry) *(u32x2*)(kp + (size_t)(n0 + j) * 8192) = o;
                S = d[j] * S + (f32x4){bflo(w[j].x), bfhi(w[j].x), bflo(w[j].y), bfhi(w[j].y)}; } }
    }
}
__device__ void gla3_item(const Params& p, int l, int item, LAS unsigned char* lds) {
    const int t = otid(), half = t >> 8, t4 = t & 255, wv = (t >> 6) & 3, lane = t & 63, fr = lane & 15, fq = lane >> 4;
    const int pair = item % (GCH / 2), bh = item / (GCH / 2), b = bh >> 2, h = bh & 3, n = pair * 2 + half;
    bf16_t* proj = (bf16_t*)(p.ws + WS_PROJ);
    LAS unsigned char* hl = lds + half * GL_HALF;
    const int dk = t4 & 63, seg = t4 >> 6;
    GlaLoads L; gla_issue_loads(L, proj, b, h, n, dk, seg, t4, true);
    const bf16_t* spT = (const bf16_t*)((const unsigned char*)p.out + OS_KVT) + ((size_t)bh * GCH + n) * 8192;
    bf16x8 spf[8][2];
#pragma unroll
    for (int nt = 0; nt < 8; ++nt)
#pragma unroll
        for (int ks = 0; ks < 2; ++ks) spf[nt][ks] = *(const bf16x8*)(spT + (nt * 16 + fr) * 64 + ks * 32 + fq * 8);
    const int rb = n * 64 + wv * 16 + fr, rbc = rb < TB ? rb : TB - 1;
    bf16_t* rowp = proj + (size_t)(b * TB + rbc) * NPROJ;
    u32x2 rwv[8];
#pragma unroll
    for (int nt = 0; nt < 8; ++nt) rwv[nt] = *(const u32x2*)(rowp + C_R + h * 128 + nt * 16 + 4 * fq);
    __syncthreads();
    float bc[16];
    (void)gla_cumsum(p, l, L, h, n, dk, seg, hl, bc);
#pragma unroll
    for (int i = 0; i < 16; ++i) { const int rbi = n * 64 + seg * 16 + i, row = seg * 16 + i;
        const float qv = rbi < TB ? bf2f(L.xq[i]) * 0.125f * __expf(bc[i]) : 0.f, kv = rbi < TB ? bf2f(L.xk[i]) * __expf(-bc[i]) : 0.f;
        *(LAS bf16_t*)(hl + GL_QD + row * 144 + dk * 2) = f2bf(qv); *(LAS bf16_t*)(hl + GL_KI + row * 144 + dk * 2) = f2bf(kv); }
    gla_store_vT(L, n, t4, hl);
    __syncthreads();
    bf16x8 qf[2];
#pragma unroll
    for (int ks = 0; ks < 2; ++ks) qf[ks] = *(const LAS bf16x8*)(hl + GL_QD + (wv * 16 + fr) * 144 + (ks * 32 + fq * 8) * 2);
#pragma unroll
    for (int st = 0; st < 4; ++st) { f32x4 acc = (f32x4){0.f, 0.f, 0.f, 0.f};
        if (st <= wv) {
#pragma unroll
            for (int ks = 0; ks < 2; ++ks) { const bf16x8 cf = *(const LAS bf16x8*)(hl + GL_KI + (st * 16 + fr) * 144 + (ks * 32 + fq * 8) * 2); acc = mfma16(cf, qf[ks], acc); }
            const int c = wv * 16 + fr, s0 = st * 16 + 4 * fq;
#pragma unroll
            for (int r = 0; r < 4; ++r) if (s0 + r > c) acc[r] = 0.f;
        }
        u32x2 w; w.x = cvt_pk_bf16(acc[0], acc[1]); w.y = cvt_pk_bf16(acc[2], acc[3]);
        *(LAS u32x2*)(hl + GL_P + (wv * 16 + fr) * 144 + (st * 16 + 4 * fq) * 2) = w; }
    __syncthreads();
    bf16x8 pf[2];
#pragma unroll
    for (int ks = 0; ks < 2; ++ks) pf[ks] = *(const LAS bf16x8*)(hl + GL_P + (wv * 16 + fr) * 144 + (ks * 32 + fq * 8) * 2);
    f32x4 o[8]; float ss = 0.f;
#pragma unroll
    for (int nt = 0; nt < 8; ++nt) { f32x4 acc = (f32x4){0.f, 0.f, 0.f, 0.f};
#pragma unroll
        for (int ks = 0; ks < 2; ++ks) { const bf16x8 cf = *(const LAS bf16x8*)(hl + GL_VT + (nt * 16 + fr) * 144 + (ks * 32 + fq * 8) * 2); acc = mfma16(cf, pf[ks], acc); }
#if !MK_NO_INTER
#pragma unroll
        for (int ks = 0; ks < 2; ++ks) acc = mfma16(spf[nt][ks], qf[ks], acc);
#endif
        o[nt] = acc; ss += acc[0] * acc[0] + acc[1] * acc[1] + acc[2] * acc[2] + acc[3] * acc[3]; }
    ss += shx(ss, lane, 16); ss += shx(ss, lane, 32);
    const float rstd = rsqrtf(ss * (1.0f / 128.0f) + EPS);
    if (rb < TB) { const float* gn = p.gla_norm + (size_t)l * 512 + h * 128;
#pragma unroll
        for (int nt = 0; nt < 8; ++nt) { const int dv = nt * 16 + 4 * fq; const f32x4 gv = *(const f32x4*)(gn + dv); const u32x2 rw = rwv[nt];
            const float v0 = o[nt][0] * rstd * gv[0] * siluf_(bflo(rw.x)), v1 = o[nt][1] * rstd * gv[1] * siluf_(bfhi(rw.x)),
                        v2 = o[nt][2] * rstd * gv[2] * siluf_(bflo(rw.y)), v3 = o[nt][3] * rstd * gv[3] * siluf_(bfhi(rw.y));
            u32x2 w; w.x = cvt_pk_bf16(v0, v1); w.y = cvt_pk_bf16(v2, v3); if (!p.dry) *(u32x2*)(rowp + C_V + h * 128 + dv) = w; } }
}

__device__ __forceinline__ int mix_item(int r, int bid, int nblk) {
    const int pos = r * nblk + ((r & 1) ? nblk - 1 - bid : bid);
    if (pos >= S5_ITEMS + GLA_ITEMS) return -1;
    if (pos < 32) return 480 + pos;
    if (pos < S5_ITEMS) return pos - 32;
    return pos;
}
__device__ void tail_glu(const Params& p, int l, LAS unsigned char* lds) {
    const int t = otid(), w = t >> 6, lane = t & 63, fr = lane & 15, fq = lane >> 4, nt = w & 1, kq = w >> 1;
    bf16_t* proj = (bf16_t*)(p.ws + WS_PROJ); const bf16_t* Bt = (const bf16_t*)(p.ws + WS_W) + W_GLU;
    for (int piece = p.bid; piece < 256; piece += p.nblk) {
        const int row = MP - 256 + (piece >> 4) * 16 + fr, colw = (piece & 15) * 32 + nt * 16;
        bf16x8 a[4], b[4];
#pragma unroll
        for (int ks = 0; ks < 4; ++ks) { a[ks] = *(const bf16x8*)(proj + (size_t)row * NPROJ + C_U + kq * 128 + ks * 32 + fq * 8); b[ks] = *(const bf16x8*)(Bt + (size_t)(colw + fr) * 512 + kq * 128 + ks * 32 + fq * 8); }
        const int col = colw + 4 * fq;
        const u32x2 aw = *(const u32x2*)(proj + (size_t)row * NPROJ + C_U + col); const f32x4 bias = *(const f32x4*)(p.b_glu + (size_t)l * 512 + col);
        f32x4 acc = (f32x4){0.f, 0.f, 0.f, 0.f};
#pragma unroll
        for (int ks = 0; ks < 4; ++ks) acc = mfma16(b[ks], a[ks], acc);
        __syncthreads();
        *(LAS f32x4*)(lds + (w * 64 + lane) * 16) = acc;
        __syncthreads();
        if (w < 2) { f32x4 s = acc;
#pragma unroll
            for (int q = 1; q < 4; ++q) s += *(const LAS f32x4*)(lds + ((nt + 2 * q) * 64 + lane) * 16);
            const f32x4 act = (f32x4){bflo(aw.x), bfhi(aw.x), bflo(aw.y), bfhi(aw.y)}, o = act * sig4(s + bias);
            u32x2 ow; ow.x = cvt_pk_bf16(o[0], o[1]); ow.y = cvt_pk_bf16(o[2], o[3]); *(u32x2*)(proj + (size_t)row * NPROJ + C_GLU + col) = ow; }
    }
    __syncthreads();
}
__device__ void tail_mix(const Params& p, LAS unsigned char* lds) {
    const int t = otid(), w = t >> 6, lane = t & 63, fr = lane & 15, fq = lane >> 4, nt = w & 3, which = w >> 2;
    const bf16_t* proj = (const bf16_t*)(p.ws + WS_PROJ); const bf16_t* Bt = (const bf16_t*)(p.ws + WS_W) + (which ? W_PB : W_PA);
    bf16_t* mixed = (bf16_t*)((unsigned char*)p.out + OS_Z);
    for (int piece = p.bid; piece < 256; piece += p.nblk) {
        const int row = MP - 256 + (piece >> 4) * 16 + fr, colw = (piece & 15) * 64 + nt * 16, col = colw + 4 * fq;
        const bf16_t* ap = proj + (size_t)row * NPROJ + (which ? C_V : C_GLU); const bf16_t* bp = Bt + (size_t)(colw + fr) * 512;
        const u32x2 gaw = *(const u32x2*)(proj + (size_t)row * NPROJ + C_GA + col), gbw = *(const u32x2*)(proj + (size_t)row * NPROJ + C_GB + col);
        f32x4 acc = (f32x4){0.f, 0.f, 0.f, 0.f};
#pragma unroll
        for (int half = 0; half < 2; ++half) { bf16x8 a[8], b[8];
#pragma unroll
            for (int ks = 0; ks < 8; ++ks) { a[ks] = *(const bf16x8*)(ap + half * 256 + ks * 32 + fq * 8); b[ks] = *(const bf16x8*)(bp + half * 256 + ks * 32 + fq * 8); }
#pragma unroll
            for (int ks = 0; ks < 8; ++ks) acc = mfma16(b[ks], a[ks], acc); }
        __syncthreads();
        if (which) *(LAS f32x4*)(lds + (nt * 64 + lane) * 16) = acc;
        __syncthreads();
        if (!which) { const f32x4 accb = *(const LAS f32x4*)(lds + (nt * 64 + lane) * 16);
            const f32x4 ga = (f32x4){bflo(gaw.x), bfhi(gaw.x), bflo(gaw.y), bfhi(gaw.y)}, gb = (f32x4){bflo(gbw.x), bfhi(gbw.x), bflo(gbw.y), bfhi(gbw.y)};
            const f32x4 o = acc * sig4(ga) + accb * sig4(gb);
            u32x2 ow; ow.x = cvt_pk_bf16(o[0], o[1]); ow.y = cvt_pk_bf16(o[2], o[3]); *(u32x2*)(mixed + (size_t)row * DM + col) = ow; }
    }
    __syncthreads();
}

#define XB_TMO      128
#define XB_XCNT(j)  (256  + 64 * (j))
#define XB_XSUB(j)  (1280 + 64 * (j))
#define XB_XGEN(j)  (2304 + 64 * (j))
#define XB_TOP      3328
#define XB_TOPGEN   3392
#define XCD_BAR_WORDS 3456
#define XB_SPIN_CAP (1u << 20)
__device__ __forceinline__ unsigned xb_ld(unsigned* p)              { return __hip_atomic_load(p, __ATOMIC_RELAXED, __HIP_MEMORY_SCOPE_AGENT); }
__device__ __forceinline__ unsigned xb_add(unsigned* p, unsigned v) { return __hip_atomic_fetch_add(p, v, __ATOMIC_RELAXED, __HIP_MEMORY_SCOPE_AGENT); }
__device__ __forceinline__ unsigned xb_xcc_id() { return (unsigned)__builtin_amdgcn_s_getreg((3 << 11) | 20) & 0xFu; }
#define XB_SPIN(cond, bar) do { unsigned _sp = 0; while (cond) { __builtin_amdgcn_s_sleep(1); \
    if ((++_sp & 255u) == 0u) { if (xb_ld(&(bar)[XB_TMO])) break; if (_sp > XB_SPIN_CAP) { atomicAdd(&(bar)[XB_TMO], 1u); break; } } } } while (0)
struct XcdBarrier { unsigned* bar; unsigned x; volatile LAS unsigned* st; };
__device__ __forceinline__ XcdBarrier xcd_barrier_post(unsigned* bar, volatile LAS unsigned* st) {
    XcdBarrier b; b.bar = bar; b.x = xb_xcc_id(); b.st = st;
    if (threadIdx.x == 0) (void)xb_add(&bar[XB_XCNT(b.x)], 1u);
    return b;
}
__device__ __forceinline__ void xcd_barrier_complete(unsigned* bar, unsigned x, unsigned& nloc, unsigned& nx) {
    const unsigned G = gridDim.x * gridDim.y * gridDim.z;
    unsigned sum, cnt, mine, sp = 0u;
    for (;;) {
        sum = 0u; cnt = 0u; mine = 0u;
#pragma unroll
        for (unsigned j = 0; j < 16; ++j) { const unsigned c = xb_ld(&bar[XB_XCNT(j)]); sum += c; cnt += (c > 0u) ? 1u : 0u; mine = (j == x) ? c : mine; }
        if (sum == G) break;
        __builtin_amdgcn_s_sleep(1);
        if ((++sp & 255u) == 0u) { if (xb_ld(&bar[XB_TMO])) break; if (sp > XB_SPIN_CAP) { atomicAdd(&bar[XB_TMO], 1u); break; } }
    }
    nloc = mine > 0u ? mine : 1u; nx = cnt > 0u ? cnt : 1u;
}
__device__ __forceinline__ void xcd_barrier(const XcdBarrier& b) {
    asm volatile("s_waitcnt vmcnt(0)" ::: "memory");
    __syncthreads();
    if (threadIdx.x == 0) {
        unsigned* bar = b.bar;
        __builtin_amdgcn_s_waitcnt(0);
        unsigned nloc = b.st[0], nx = b.st[1];
        if (nloc == 0u) { xcd_barrier_complete(bar, b.x, nloc, nx); b.st[0] = nloc; b.st[1] = nx; }
        const unsigned old = xb_add(&bar[XB_XSUB(b.x)], 1u);
        const unsigned gen = old / nloc;
        if (old + 1u == (gen + 1u) * nloc) {
            __builtin_amdgcn_fence(__ATOMIC_RELEASE, "agent");
            asm volatile("s_waitcnt vmcnt(0)" ::: "memory");
            const unsigned og = xb_add(&bar[XB_TOP], 1u);
            const unsigned tg = og / nx;
            if (og + 1u == (tg + 1u) * nx) xb_add(&bar[XB_TOPGEN], 1u);
            else XB_SPIN(xb_ld(&bar[XB_TOPGEN]) == tg, bar);
            __builtin_amdgcn_fence(__ATOMIC_ACQUIRE, "agent");
            xb_add(&bar[XB_XGEN(b.x)], 1u);
            asm volatile("s_waitcnt vmcnt(0)" ::: "memory");
        } else {
            XB_SPIN(xb_ld(&bar[XB_XGEN(b.x)]) == gen, bar);
            __builtin_amdgcn_fence(__ATOMIC_ACQUIRE, "agent");
            asm volatile("s_waitcnt vmcnt(0)" ::: "memory");
        }
    }
    __syncthreads();
}

constexpr int NPHASE = 2 + 11 * DEPTH;
__device__ void run_phase(const Params& p, int ph, LAS unsigned char* lds) {
    bf16_t* hres = (bf16_t*)(p.ws + WS_H);
    bf16_t* proj = (bf16_t*)(p.ws + WS_PROJ);
    bf16_t* W = (bf16_t*)(p.ws + WS_W);
    bf16_t* z = (bf16_t*)((unsigned char*)p.out + OS_Z);
    bf16_t* hy = (bf16_t*)(p.ws + WS_Y);
    float* ssq1 = (float*)(p.ws + WS_SSQ1); float* ssq2 = (float*)(p.ws + WS_SSQ2); float* rs1 = (float*)(p.ws + WS_RS1); float* rs2 = (float*)(p.ws + WS_RS2);
    float* ldsf = (float*)(unsigned char*)lds;
    pg8::StaticOrder S;
    if (ph == 0) {
        for (int it = p.bid; it < NCONV_MIX + 256; it += p.nblk) { if (it < NCONV_MIX) conv_mixer_item(p, 0, it, ldsf); else s5_prep_item(p, 0, it - NCONV_MIX, ldsf); }
        init_h(p); return; }
    if (ph == NPHASE - 1) { final_norm(p, hres, p.norm_f, p.out); return; }
    const int l = (ph - 1) / 11, s = (ph - 1) % 11;
    if (l >= MK_LAYERS || s > MK_LAST_S) return;
    switch (s) {
    case 0:
        if (l > 0) fold_rows(p, 11, ssq1, rs1);
        break;
    case 1: { S.init(MP, NPROJ, 1024, p.nblk, p.bid); pg8::gemm_phase(lds, pg8::Gemm{hres, W + W_IN, MP, NPROJ, 1024, 1024, nullptr, nullptr}, S, EpiStore{proj, NPROJ, rs1}); }
        { const int first = (MP / 256 * (NPROJ / 256)) % p.nblk;
          if (p.bid >= first && first > 0) for (int it = p.bid - first; it < 352; it += p.nblk - first) conv_ff_item(p, l, it, ldsf); else if (first == 0) for (int it = p.bid; it < 352; it += p.nblk) conv_ff_item(p, l, it, ldsf); }
        break;
    case 2:
        for (int it = p.bid; it < S5_ITEMS + GLA_ITEMS; it += p.nblk) { if (it < S5_ITEMS) s5a_item(p, it, lds); else gla1_item(p, l, it - S5_ITEMS, lds); }
        break;
    case 3:
        if (otid() < 64) s5_scan(p);
#if !MK_NO_GSCAN
        else gla_scan(p);
#endif
        break;
    case 4:
        for (int it = p.bid; it < S5_ITEMS + GLA_ITEMS; it += p.nblk) { if (it < S5_ITEMS) s5c_item(p, l, it, lds); else gla3_item(p, l, it - S5_ITEMS, lds); }
        break;
    case 5: { tail_glu(p, l, lds); S.init(MP - 256, 512, 512, p.nblk, p.bid); pg8::gemm_phase(lds, pg8::Gemm{proj + C_U, W + W_GLU, MP - 256, 512, 512, NPROJ, nullptr, nullptr}, S, EpiGlu{proj, p.b_glu + (size_t)l * 512}); }
        if (l + 1 < DEPTH) for (int it = p.bid; it < 256; it += p.nblk) s5_prep_item(p, l + 1, it, ldsf);
        break;
    case 6: { tail_mix(p, lds); S.init(MP - 256, 1024, 512, p.nblk, p.bid, 0, 1);
        pg8::gemm_phase(lds, pg8::Gemm{proj + C_GLU, W + W_PA, MP - 256, 1024, 512, NPROJ, proj + C_V, W + W_PB}, S, EpiMixPair{proj + C_GA, proj + C_GB, z}); } break;
    case 7: { S.init(MP, 1024, 1024, p.nblk, p.bid, 4); pg8::gemm_phase(lds, pg8::Gemm{z, W + W_OUT, MP, 1024, 1024, 1024, nullptr, nullptr}, S, EpiRes{hres, p.dry ? 0.f : 1.f, (float*)(p.ws + WS_PART), ssq2}); }
        break;
    case 8:
        fold_rows(p, 4, ssq2, rs2); break;
    case 9: { S.init(MP, 2 * DFF, 1024, p.nblk, p.bid); pg8::gemm_phase(lds, pg8::Gemm{hres, W + W_FF13, MP, 2 * DFF, 1024, 1024, nullptr, nullptr}, S, EpiFF{proj, rs2}); }
        { const int first = (MP / 256 * (2 * DFF / 256)) % p.nblk, nmix = l + 1 < DEPTH ? NCONV_MIX : 0;
          const int i0 = first > 0 ? p.bid - first : p.bid, st = first > 0 ? p.nblk - first : p.nblk;
          if (i0 >= 0) for (int it = i0; it < nmix + 176; it += st) { if (it < nmix) conv_mixer_item(p, l + 1, it, ldsf); else conv_ff_item(p, l, 352 + it - nmix, ldsf); } }
        break;
    case 10: { S.init(MP, 1024, DFF, p.nblk, p.bid, 11); pg8::gemm_phase(lds, pg8::Gemm{proj, W + W_FF2, MP, 1024, DFF, DFF, nullptr, nullptr}, S, EpiRes{hres, p.dry ? 0.f : 1.f, (float*)(p.ws + WS_PART), ssq1}); }
        break;
    }
}

typedef const float* fptr_t;
typedef __attribute__((address_space(4))) const fptr_t kfptr_t;
__global__ void __launch_bounds__(512, 2) hybrid_fwd(Params p0) {
    extern __shared__ __attribute__((aligned(16))) unsigned char shm[];
    LAS unsigned char* lds = (LAS unsigned char*)shm;
    cg::grid_group grid = cg::this_grid();
    const int ph_lo = p0.ph_lo, ph_hi = p0.ph_hi;
    volatile LAS unsigned* xst = (volatile LAS unsigned*)(lds + 131072);
    if (threadIdx.x == 0) { xst[0] = 0u; xst[1] = 0u; }
    __syncthreads();
    XcdBarrier xb = xcd_barrier_post((unsigned*)(p0.ws + WS_BAR), xst);
    for (int ph = ph_lo; ph < ph_hi; ++ph) {
        if (ph == 1 && MK_ONE_LAUNCH) continue;
        int reps = (MK_DUP >= 0 && ph >= 1 && ph < NPHASE - 1 && (ph - 1) % 11 == MK_DUP) ? 2 : 1;
        for (int rep = 0; rep < reps; ++rep) {
        kfptr_t* tab = (kfptr_t*)__builtin_amdgcn_kernarg_segment_ptr(); asm volatile("" : "+s"(tab));
        Params p;
        p.x = tab[0]; p.meta = tab[1]; p.norm1 = tab[2]; p.w_in = tab[3]; p.lam_re = tab[4]; p.lam_im = tab[5]; p.log_step = tab[6]; p.b_re = tab[7]; p.b_im = tab[8];
        p.c_re = tab[9]; p.c_im = tab[10]; p.d_skip = tab[11]; p.w_glu = tab[12]; p.b_glu = tab[13]; p.w_pa = tab[14]; p.w_alpha = tab[15]; p.b_alpha = tab[16];
        p.gla_norm = tab[17]; p.w_pb = tab[18]; p.w_out = tab[19]; p.norm2 = tab[20]; p.w_ff1 = tab[21]; p.w_ff3 = tab[22]; p.w_ff2 = tab[23]; p.norm_f = tab[24];
        p.out = (float*)tab[25]; p.ws = (unsigned char*)tab[26]; p.ph_lo = ph_lo; p.ph_hi = ph_hi;
        int bid = blockIdx.x, nblk = gridDim.x; asm volatile("" : "+s"(bid)); asm volatile("" : "+s"(nblk));
        p.bid = bid; p.nblk = nblk; p.dry = (reps == 2 && rep == 0 && MK_DUP_DRY) ? 1 : 0; p.pad_ = 0;
        run_phase(p, ph, lds);
        if (rep + 1 < reps || ph + 1 < ph_hi) {
            if (ph == ph_lo && rep == 0) grid.sync();
            else { xb.bar = (unsigned*)(p.ws + WS_BAR); xcd_barrier(xb); } }
        if (MK_DUP == 99) { xb.bar = (unsigned*)(p.ws + WS_BAR); xcd_barrier(xb); }
        }
    }
}

extern "C" void kernel_launch(void* const* d_in, const int* in_sizes, int n_in, void* d_out, int out_size, void* d_ws, size_t ws_size, hipStream_t stream) {
    static int grid = 0;
    if (grid == 0) {
        if (n_in != 25 || ws_size < WS_END) { fprintf(stderr, "kernel_launch: unexpected n_in %d or ws_size %zu (< %zu)\n", n_in, ws_size, (size_t)WS_END); grid = -1; return; }
        int dev = 0, cus = 0, per_cu = 0;
        hipGetDevice(&dev); hipDeviceGetAttribute(&cus, hipDeviceAttributeMultiprocessorCount, dev);
        if (hipFuncSetAttribute((const void*)hybrid_fwd, hipFuncAttributeMaxDynamicSharedMemorySize, LDS_BYTES) != hipSuccess) { fprintf(stderr, "kernel_launch: hipFuncSetAttribute failed\n"); grid = -1; return; }
        if (hipOccupancyMaxActiveBlocksPerMultiprocessor(&per_cu, (const void*)hybrid_fwd, 512, LDS_BYTES) != hipSuccess || per_cu < 1) { fprintf(stderr, "kernel_launch: occupancy query says %d\n", per_cu); per_cu = 1; }
        (void)hipGetLastError();
        grid = cus * per_cu;
    }
    if (grid < 0) return;
    Params p{};
    const float** pp = (const float**)&p;
    for (int i = 0; i < 25; ++i) pp[i] = (const float*)d_in[i];
    p.out = (float*)d_out; p.ws = (unsigned char*)d_ws;
#if MK_ONE_LAUNCH
    p.ph_lo = 0; p.ph_hi = NPHASE;
    (void)hipMemsetAsync((char*)d_ws + WS_BAR, 0, 16384, stream);
    void* args[] = {&p};
    hipError_t e = hipLaunchCooperativeKernel((const void*)hybrid_fwd, dim3(grid), dim3(512), args, LDS_BYTES, stream);
    if (e != hipSuccess) fprintf(stderr, "cooperative launch failed: %s (grid %d)\n", hipGetErrorString(e), grid);
#else
    for (int ph = 0; ph < NPHASE; ++ph) { p.ph_lo = ph; p.ph_hi = ph + 1; hipLaunchKernelGGL(hybrid_fwd, dim3(grid), dim3(512), LDS_BYTES, stream, p); }
#endif
}
```

```cpp
#include <hip/hip_runtime.h>
#include <hip/hip_cooperative_groups.h>
#include <cstdio>
namespace cg = cooperative_groups;

#ifndef MK_DRY_S5ONLY
#define MK_DRY_S5ONLY 0
#endif
#ifndef MK_DUP_DRY
#define MK_DUP_DRY 0
#endif
#ifndef MK_DUP
#define MK_DUP -1
#endif
#ifndef MK_NO_GSCAN
#define MK_NO_GSCAN 0
#endif
#ifndef MK_NO_INTER
#define MK_NO_INTER 0
#endif
#ifndef MK_BRANCH
#define MK_BRANCH 0
#endif
#ifndef MK_LAYERS
#define MK_LAYERS 4
#endif
#ifndef MK_LAST_S
#define MK_LAST_S 10
#endif
#ifndef MK_ONE_LAUNCH
#define MK_ONE_LAUNCH 1
#endif

#define LAS __attribute__((address_space(3)))
typedef unsigned short bf16_t;
typedef short bf16x8 __attribute__((ext_vector_type(8)));
typedef float f32x4 __attribute__((ext_vector_type(4)));
typedef float f32x2 __attribute__((ext_vector_type(2)));
typedef unsigned u32x4 __attribute__((ext_vector_type(4)));
typedef unsigned u32x2 __attribute__((ext_vector_type(2)));

constexpr int DM = 1024, NBATCH = 8, SEQ = 4096, NMETA = 16, DEPTH = 4;
constexpr int TB = 4128;
constexpr int MP = NBATCH * TB;
constexpr int NPROJ = 4352;
constexpr int DFF = 2816;
constexpr int C_U = 0, C_Q = 512, C_K = 768, C_V = 1024, C_R = 1536, C_GL = 2048, C_GA = 2304, C_GB = 3328;
constexpr int C_GLU = 512;
constexpr int NCH16 = MP / 16;
constexpr int GCH = 66;
constexpr float EPS = 1e-6f;

constexpr size_t WS_H = 0;
constexpr size_t WS_PROJ = WS_H + (size_t)MP * DM * 4;
constexpr size_t WS_W = WS_PROJ + (size_t)MP * NPROJ * 2 + 65536;
constexpr size_t W_IN = 0, W_GLU = W_IN + (size_t)NPROJ * 1024, W_PA = W_GLU + 512 * 512, W_PB = W_PA + 1024 * 512, W_OUT = W_PB + 1024 * 512,
                 W_FF13 = W_OUT + 1024 * 1024, W_FF2 = W_FF13 + (size_t)2 * DFF * 1024, W_END = W_FF2 + (size_t)1024 * DFF;
constexpr size_t WS_XLOC = WS_W + W_END * 2;
constexpr size_t WS_WY = WS_XLOC + (size_t)NCH16 * 32 * 128 * 4;
constexpr size_t WS_WE = WS_WY + (size_t)32 * 256 * 384 * 2;
constexpr size_t WS_A16 = WS_WE + (size_t)32 * 128 * 256 * 2;
constexpr size_t WS_DECAY = WS_A16 + 32 * 64 * 2 * 4;
constexpr size_t WS_PART = WS_DECAY + (size_t)32 * GCH * 64 * 4;
constexpr size_t WS_BAR = WS_PART + (size_t)11 * 256 * 1024 * 4;
constexpr size_t WS_SSQ1 = WS_BAR + 16384;
constexpr size_t WS_SSQ2 = WS_SSQ1 + (size_t)MP * 16 * 4;
constexpr size_t WS_RS1 = WS_SSQ2 + (size_t)MP * 16 * 4;
constexpr size_t WS_RS2 = WS_RS1 + (size_t)MP * 4;
constexpr size_t WS_TZ = WS_RS2 + (size_t)MP * 4;
constexpr size_t WS_END = WS_TZ + (size_t)32 * 16 * 512 * 2;
constexpr size_t WS_Y = WS_PROJ + (size_t)MP * DFF * 2;
constexpr size_t OS_Z = 0;
constexpr size_t OS_KVT = (size_t)MP * DM * 2;
constexpr size_t OS_END = OS_KVT + (size_t)32 * GCH * 8192 * 2;
static_assert(OS_END <= (size_t)NBATCH * SEQ * DM * 4, "d_out scratch overflow");
static_assert(WS_END <= (size_t)512 * 1024 * 1024, "workspace overflow");

constexpr int LDS_BYTES = 131072 + 16;

struct Params {
    const float *x, *meta, *norm1, *w_in, *lam_re, *lam_im, *log_step, *b_re, *b_im, *c_re, *c_im, *d_skip, *w_glu, *b_glu, *w_pa, *w_alpha, *b_alpha,
        *gla_norm, *w_pb, *w_out, *norm2, *w_ff1, *w_ff3, *w_ff2, *norm_f;
    float* out; unsigned char* ws; int ph_lo, ph_hi, bid, nblk, dry, pad_;
};

__device__ __forceinline__ float bf2f(bf16_t b) { return __uint_as_float(((unsigned)b) << 16); }
__device__ __forceinline__ float bflo(unsigned w) { return __uint_as_float(w << 16); }
__device__ __forceinline__ float bfhi(unsigned w) { return __uint_as_float(w & 0xffff0000u); }
typedef __bf16 bf16n2 __attribute__((ext_vector_type(2)));
__device__ __forceinline__ unsigned cvt_pk_bf16(float lo, float hi) { const f32x2 f = {lo, hi}; const bf16n2 v = __builtin_convertvector(f, bf16n2); return __builtin_bit_cast(unsigned, v); }
__device__ __forceinline__ bf16_t f2bf(float f) { return (bf16_t)(cvt_pk_bf16(f, 0.f) & 0xffffu); }
__device__ __forceinline__ float sigmoidf_(float x) { return __builtin_amdgcn_rcpf(1.0f + __expf(-x)); }
__device__ __forceinline__ float siluf_(float x) { return x * sigmoidf_(x); }
__device__ __forceinline__ float logsigmoidf_(float x) { return fminf(x, 0.f) - __logf(1.0f + __expf(-fabsf(x))); }
__device__ __forceinline__ float gelu_tanh(float x) { const float u = 0.7978845608f * (x + 0.044715f * x * x * x); return x * sigmoidf_(2.f * u); }
__device__ __forceinline__ f32x4 mfma16(bf16x8 colfrag, bf16x8 rowfrag, f32x4 acc) { return __builtin_amdgcn_mfma_f32_16x16x32_bf16(colfrag, rowfrag, acc, 0, 0, 0); }
__device__ __forceinline__ int otid() { int t = threadIdx.x; asm volatile("" : "+v"(t)); return t; }
__device__ __forceinline__ float shx(float v, int lane, int o) { return __int_as_float(__builtin_amdgcn_ds_bpermute((lane ^ o) << 2, __float_as_int(v))); }

struct RsPre { float rs[2][4]; };
namespace pg8 {
constexpr int BM = 256, BK = 64, HALF = 128, HTB = HALF * BK * 2, STAGE_BYTES = 8 * HTB, NXCD = 8, WGM = 8;
__host__ __device__ __forceinline__ int lds_byte(int r, int c) { const int st = (r >> 4) * 2 + (c >> 5), rr = r & 15, cc = c & 31, ob = rr * 64 + cc * 2; return st * 1024 + (ob ^ (((ob >> 9) & 1) << 5)); }
__host__ __device__ __forceinline__ void stage_rc(int b, int& R, int& C) { const int st = b / 1024, sb = b % 1024, swz = sb ^ (((sb >> 9) & 1) << 5); R = (st >> 1) * 16 + swz / 64; C = (st & 1) * 32 + (swz % 64) / 2; }
__host__ __device__ __forceinline__ int perm32(int rho) { const int n = rho >> 4, i = rho & 15; return 8 * (i >> 2) + 4 * n + (i & 3); }
struct Unit { int pm, pn, k0, nt, split, alt; };
struct Gemm { const bf16_t* A; const bf16_t* Bt; int M, N, K, lda; const bf16_t* A2; const bf16_t* Bt2; };
struct StaticOrder {
    int nM, nN, nwg, G, c, ntK, nsplit, pairs;
    __device__ void init(int M, int N, int K, int G_, int c_, int nsplit_ = 0, int pairs_ = 0) { pairs = pairs_; nM = M / BM - (nsplit_ > 0 ? 1 : 0); nN = N / BM; nwg = nM * nN; G = G_; c = c_; ntK = K / BK; nsplit = nsplit_; }
    __device__ bool next(int i, Unit& u) const {
        const long L = (long)(pairs ? (i >> 1) : i) * G + c; u.alt = pairs ? (i & 1) : 0;
        if (L >= (long)nwg + nsplit * nN) return false;
        const bool tail = L >= nwg; const int j = tail ? (int)(L - nwg) : 0, ns = nsplit > 0 ? nsplit : 1;
        int wgid = tail ? 0 : (int)L; { const int q = nwg / NXCD, r = nwg % NXCD, xcd = wgid % NXCD, off = wgid / NXCD; wgid = (xcd < r ? xcd * (q + 1) : r * (q + 1) + (xcd - r) * q) + off; }
        const int nig = WGM * nN, gid = wgid / nig, fm = gid * WGM, gsz = (nM - fm) < WGM ? (nM - fm) : WGM;
        const int pmf = fm + ((wgid % nig) % gsz), pnf = (wgid % nig) / gsz, ntt = ntK / ns;
        u.pm = tail ? nM : pmf; u.pn = tail ? j % nN : pnf; u.nt = tail ? ntt : ntK; u.k0 = tail ? (j / nN) * ntt * BK : 0; u.split = tail ? (j / nN) + 1 : 0; return true;
    }
};

template <class Epi>
__device__ __forceinline__ void gemm_phase(LAS unsigned char* lds, const Gemm g, const StaticOrder& S, const Epi& E) {
    const int tid = otid();
    const int wid = __builtin_amdgcn_readfirstlane(tid >> 6), lane = tid & 63, wr = wid >> 2, wc = wid & 3, fr = lane & 15, fq = lane >> 4;
    const int K = g.K, lda = g.lda;
    unsigned voffA[2], voffB[2];
#pragma unroll
    for (int i = 0; i < 2; ++i) { int R, C; stage_rc(tid * 16 + i * 8192, R, C); const int Rb = Epi::PERM ? ((R & ~31) + perm32(R & 31)) : R;
        voffA[i] = (unsigned)(R * lda + C) * 2u; voffB[i] = (unsigned)(Rb * K + C) * 2u; }
    const size_t kstep = (size_t)(BK * 2);
    const size_t hA = (size_t)HALF * lda * 2, hB = (size_t)HALF * K * 2;
    const size_t tA = 2 * hA, tB = 2 * hB;
    const unsigned ldsw = (unsigned)wid * 1024u;
    const int aoff = lds_byte(wr * 64 + fr, fq * 8), boff = lds_byte(wc * 32 + fr, fq * 8);
#define PG8_SA(b, h) (((b) * 2 + (h)) * HTB)
#define PG8_SB(b, h) ((4 + (b) * 2 + (h)) * HTB)
#define PG8_STAGE(bufoff, gbase, voff) do { _Pragma("unroll") for (int _i = 0; _i < 2; ++_i) \
        __builtin_amdgcn_global_load_lds((const unsigned*)((const char*)(gbase) + (voff)[_i]), (LAS unsigned*)(lds + (bufoff) + ldsw + _i * 8192), 16, 0, 0); } while (0)
#define PG8_LDA(dst, b, h) do { _Pragma("unroll") for (int m = 0; m < 4; ++m) _Pragma("unroll") for (int k = 0; k < 2; ++k) dst[m][k] = *(const LAS bf16x8*)(lds + PG8_SA(b, h) + aoff + m * 2048 + k * 1024); } while (0)
#define PG8_LDB(dst, b, h) do { _Pragma("unroll") for (int n = 0; n < 2; ++n) _Pragma("unroll") for (int k = 0; k < 2; ++k) dst[n][k] = *(const LAS bf16x8*)(lds + PG8_SB(b, h) + boff + n * 2048 + k * 1024); } while (0)
#define PG8_MMA(ai, bj, At, Bt) do { __builtin_amdgcn_s_setprio(1); _Pragma("unroll") for (int m = 0; m < 4; ++m) _Pragma("unroll") for (int n = 0; n < 2; ++n) _Pragma("unroll") for (int k = 0; k < 2; ++k) \
        acc[ai][bj][m][n] = __builtin_amdgcn_mfma_f32_16x16x32_bf16(Bt[n][k], At[m][k], acc[ai][bj][m][n], 0, 0, 0); __builtin_amdgcn_s_setprio(0); } while (0)
#define PG8_WAIT_V(n) asm volatile("s_waitcnt vmcnt(" #n ")" ::: "memory")
#define PG8_WAIT_L(n) asm volatile("s_waitcnt lgkmcnt(" #n ")" ::: "memory")
#define PG8_BAR __builtin_amdgcn_s_barrier()
#define PG8_SCHED __builtin_amdgcn_sched_barrier(0)
    Unit cur, nxt; int ui = 0;
    if (!S.next(0, cur)) return;
    f32x4 acc[2][2][4][2];
#pragma unroll
    for (int a = 0; a < 2; ++a)
#pragma unroll
        for (int b = 0; b < 2; ++b)
#pragma unroll
            for (int m = 0; m < 4; ++m)
#pragma unroll
                for (int n = 0; n < 2; ++n) acc[a][b][m][n] = (f32x4){0.f, 0.f, 0.f, 0.f};
    bf16x8 At[4][2], B0[2][2], B1[2][2];
    RsPre pre;
    if constexpr (Epi::HAS_PRE) E.pre(pre, cur, wr, fr);
    const char* cA = (const char*)(cur.alt ? g.A2 : g.A) + (size_t)cur.pm * tA + (size_t)cur.k0 * 2; const char* cB = (const char*)(cur.alt ? g.Bt2 : g.Bt) + (size_t)cur.pn * tB + (size_t)cur.k0 * 2;
    PG8_STAGE(PG8_SB(0, 0), cB, voffB); PG8_STAGE(PG8_SA(0, 0), cA, voffA); PG8_STAGE(PG8_SB(0, 1), cB + hB, voffB); PG8_STAGE(PG8_SA(0, 1), cA + hA, voffA);
    if (wr == 1) PG8_BAR;
    PG8_WAIT_V(4); PG8_BAR;
    PG8_STAGE(PG8_SB(1, 0), cB + kstep, voffB); PG8_STAGE(PG8_SA(1, 0), cA + kstep, voffA); PG8_STAGE(PG8_SB(1, 1), cB + hB + kstep, voffB);
    PG8_WAIT_V(6); PG8_BAR;
    for (;;) {
        const bool has_next = S.next(ui + 1, nxt);
        const char* nA = has_next ? (const char*)(nxt.alt ? g.A2 : g.A) + (size_t)nxt.pm * tA + (size_t)nxt.k0 * 2 : cA; const char* nB = has_next ? (const char*)(nxt.alt ? g.Bt2 : g.Bt) + (size_t)nxt.pn * tB + (size_t)nxt.k0 * 2 : cB;
        const int nt = cur.nt;
        for (int t = 0; t < nt; t += 2) {
            const bool last = (t == nt - 2);
            const char* a1 = cA + (size_t)(t + 1) * kstep;
            const char* a2 = last ? nA : cA + (size_t)(t + 2) * kstep; const char* b2 = last ? nB : cB + (size_t)(t + 2) * kstep;
            const char* a3 = a2 + kstep; const char* b3 = b2 + kstep;
            PG8_LDB(B0, 0, 0); PG8_SCHED; PG8_LDA(At, 0, 0); PG8_STAGE(PG8_SA(1, 1), a1 + hA, voffA);
            PG8_WAIT_L(8); PG8_BAR; PG8_WAIT_L(0); PG8_MMA(0, 0, At, B0); PG8_BAR; PG8_SCHED;
            PG8_LDB(B1, 0, 1); PG8_STAGE(PG8_SB(0, 0), b2, voffB);
            PG8_BAR; PG8_WAIT_L(0); PG8_MMA(0, 1, At, B1); PG8_BAR;
            PG8_LDA(At, 0, 1); PG8_STAGE(PG8_SA(0, 0), a2, voffA);
            PG8_BAR; PG8_WAIT_L(0); PG8_MMA(1, 0, At, B0); PG8_BAR; PG8_SCHED;
            PG8_STAGE(PG8_SB(0, 1), b2 + hB, voffB);
            PG8_WAIT_V(6); PG8_BAR; PG8_MMA(1, 1, At, B1); PG8_BAR;
            PG8_LDB(B0, 1, 0); PG8_SCHED; PG8_LDA(At, 1, 0); PG8_STAGE(PG8_SA(0, 1), a2 + hA, voffA);
            PG8_WAIT_L(8); PG8_BAR; PG8_WAIT_L(0); PG8_MMA(0, 0, At, B0); PG8_BAR; PG8_SCHED;
            PG8_LDB(B1, 1, 1); PG8_STAGE(PG8_SB(1, 0), b3, voffB);
            PG8_BAR; PG8_WAIT_L(0); PG8_MMA(0, 1, At, B1); PG8_BAR;
            PG8_LDA(At, 1, 1); PG8_STAGE(PG8_SA(1, 0), a3, voffA);
            PG8_BAR; PG8_WAIT_L(0); PG8_MMA(1, 0, At, B0); PG8_BAR; PG8_SCHED;
            PG8_STAGE(PG8_SB(1, 1), b3 + hB, voffB);
            PG8_WAIT_V(6); PG8_BAR; PG8_MMA(1, 1, At, B1); PG8_BAR;
        }
        if constexpr (Epi::HAS_PRE) { E(acc, cur, wr, wc, fr, fq, pre); if (has_next) E.pre(pre, nxt, wr, fr); } else E(acc, cur, wr, wc, fr, fq);
        if (!has_next) break;
        if (!(Epi::PAIRS && cur.alt == 0)) {
#pragma unroll
        for (int a = 0; a < 2; ++a)
#pragma unroll
            for (int b = 0; b < 2; ++b)
#pragma unroll
                for (int m = 0; m < 4; ++m)
#pragma unroll
                    for (int n = 0; n < 2; ++n) acc[a][b][m][n] = (f32x4){0.f, 0.f, 0.f, 0.f}; }
        cur = nxt; cA = nA; cB = nB; ++ui;
    }
    PG8_WAIT_V(0);
    if (wr == 0) PG8_BAR;
    PG8_BAR;
#undef PG8_SA
#undef PG8_SB
#undef PG8_STAGE
#undef PG8_LDA
#undef PG8_LDB
#undef PG8_MMA
#undef PG8_WAIT_V
#undef PG8_WAIT_L
#undef PG8_BAR
#undef PG8_SCHED
}
}
using pg8::Unit;
typedef f32x4 Acc[2][2][4][2];

__device__ __forceinline__ u32x4 pack8(const f32x4 a, const f32x4 b) { u32x4 w; w.x = cvt_pk_bf16(a[0], a[1]); w.y = cvt_pk_bf16(a[2], a[3]); w.z = cvt_pk_bf16(b[0], b[1]); w.w = cvt_pk_bf16(b[2], b[3]); return w; }
__device__ __forceinline__ void unpack8(const u32x4 w, f32x4& a, f32x4& b) { a = (f32x4){bflo(w.x), bfhi(w.x), bflo(w.y), bfhi(w.y)}; b = (f32x4){bflo(w.z), bfhi(w.z), bflo(w.w), bfhi(w.w)}; }
__device__ __forceinline__ f32x4 sig4(const f32x4 v) { return (f32x4){sigmoidf_(v[0]), sigmoidf_(v[1]), sigmoidf_(v[2]), sigmoidf_(v[3])}; }

__device__ __forceinline__ float row_rs(const float* ssq, int row) {
    const f32x4* q = (const f32x4*)(ssq + (size_t)row * 16); const f32x4 a = q[0], b = q[1], c = q[2], d = q[3];
    const float s = ((a[0] + a[1]) + (a[2] + a[3])) + ((b[0] + b[1]) + (b[2] + b[3])) + ((c[0] + c[1]) + (c[2] + c[3])) + ((d[0] + d[1]) + (d[2] + d[3]));
    return rsqrtf(s * (1.0f / DM) + EPS);
}
struct EpiStore {
    static constexpr bool PERM = true, HAS_PRE = true, PAIRS = false;
    bf16_t* O; int ldc; const float* rsv;
    __device__ __forceinline__ void pre(RsPre& r, const Unit& u, int wr, int fr) const {
#pragma unroll
        for (int ai = 0; ai < 2; ++ai)
#pragma unroll
            for (int m = 0; m < 4; ++m) r.rs[ai][m] = rsv[u.pm * 256 + wr * 64 + fr + ai * 128 + m * 16]; }
    __device__ __forceinline__ void operator()(const Acc& acc, const Unit& u, int wr, int wc, int fr, int fq, const RsPre& pr) const {
        asm volatile("" : "+v"(fr), "+v"(fq));
        const int row0 = u.pm * 256 + wr * 64 + fr, col0 = u.pn * 256 + wc * 32 + 8 * fq;
        const float (&rs)[2][4] = pr.rs;
#pragma unroll
        for (int ai = 0; ai < 2; ++ai)
#pragma unroll
            for (int m = 0; m < 4; ++m) { bf16_t* rowp = O + (size_t)(row0 + ai * 128 + m * 16) * ldc + col0;
#pragma unroll
                for (int bj = 0; bj < 2; ++bj) *(u32x4*)(rowp + bj * 128) = pack8(acc[ai][bj][m][0] * rs[ai][m], acc[ai][bj][m][1] * rs[ai][m]); }
    }
};
struct EpiGlu {
    static constexpr bool PERM = true, HAS_PRE = false, PAIRS = false;
    bf16_t* proj; const float* bias;
    __device__ __forceinline__ void operator()(const Acc& acc, const Unit& u, int wr, int wc, int fr, int fq) const {
        asm volatile("" : "+v"(fr), "+v"(fq));
        const int row0 = u.pm * 256 + wr * 64 + fr, col0 = u.pn * 256 + wc * 32 + 8 * fq;
        f32x4 bv[2][2];
#pragma unroll
        for (int bj = 0; bj < 2; ++bj)
#pragma unroll
            for (int n = 0; n < 2; ++n) bv[bj][n] = *(const f32x4*)(bias + col0 + bj * 128 + 4 * n);
#pragma unroll
        for (int ai = 0; ai < 2; ++ai) {
            u32x4 av[4][2];
#pragma unroll
            for (int m = 0; m < 4; ++m)
#pragma unroll
                for (int bj = 0; bj < 2; ++bj) av[m][bj] = *(const u32x4*)(proj + (size_t)(row0 + ai * 128 + m * 16) * NPROJ + col0 + bj * 128);
#pragma unroll
            for (int m = 0; m < 4; ++m) { bf16_t* rowp = proj + (size_t)(row0 + ai * 128 + m * 16) * NPROJ + col0;
#pragma unroll
                for (int bj = 0; bj < 2; ++bj) { f32x4 a0, a1; unpack8(av[m][bj], a0, a1);
                    const f32x4 o0 = a0 * sig4(acc[ai][bj][m][0] + bv[bj][0]), o1 = a1 * sig4(acc[ai][bj][m][1] + bv[bj][1]);
                    *(u32x4*)(rowp + C_GLU + bj * 128) = pack8(o0, o1); } } }
    }
};
template <int SECOND> struct EpiMix {
    static constexpr bool PERM = true, HAS_PRE = false, PAIRS = false;
    const bf16_t* gate; bf16_t* mixed;
    __device__ __forceinline__ void operator()(const Acc& acc, const Unit& u, int wr, int wc, int fr, int fq) const {
        asm volatile("" : "+v"(fr), "+v"(fq));
        const int row0 = u.pm * 256 + wr * 64 + fr, col0 = u.pn * 256 + wc * 32 + 8 * fq;
#pragma unroll
        for (int ai = 0; ai < 2; ++ai) {
            u32x4 gv[4][2], pv[4][2];
#pragma unroll
            for (int m = 0; m < 4; ++m)
#pragma unroll
                for (int bj = 0; bj < 2; ++bj) { const size_t row = (size_t)(row0 + ai * 128 + m * 16);
                    gv[m][bj] = *(const u32x4*)(gate + row * NPROJ + col0 + bj * 128);
                    if (SECOND) pv[m][bj] = *(const u32x4*)(mixed + row * 1024 + col0 + bj * 128); }
#pragma unroll
            for (int m = 0; m < 4; ++m) { const size_t row = (size_t)(row0 + ai * 128 + m * 16);
#pragma unroll
                for (int bj = 0; bj < 2; ++bj) { f32x4 g0, g1; unpack8(gv[m][bj], g0, g1);
                    f32x4 o0 = acc[ai][bj][m][0] * sig4(g0), o1 = acc[ai][bj][m][1] * sig4(g1);
                    if (SECOND) { f32x4 p0, p1; unpack8(pv[m][bj], p0, p1); o0 += p0; o1 += p1; }
                    *(u32x4*)(mixed + row * 1024 + col0 + bj * 128) = pack8(o0, o1); } } }
    }
};
struct EpiMixPair {
    static constexpr bool PERM = true, HAS_PRE = false, PAIRS = true;
    const bf16_t* ga; const bf16_t* gb; bf16_t* mixed;
    __device__ __forceinline__ void operator()(Acc& acc, const Unit& u, int wr, int wc, int fr, int fq) const {
        asm volatile("" : "+v"(fr), "+v"(fq));
        const int row0 = u.pm * 256 + wr * 64 + fr, col0 = u.pn * 256 + wc * 32 + 8 * fq;
#pragma unroll
        for (int ai = 0; ai < 2; ++ai) {
            u32x4 av[4][2], bv[4][2];
#pragma unroll
            for (int m = 0; m < 4; ++m)
#pragma unroll
                for (int bj = 0; bj < 2; ++bj) { const size_t off = (size_t)(row0 + ai * 128 + m * 16) * NPROJ + col0 + bj * 128;
                    bv[m][bj] = *(const u32x4*)(gb + off); if (u.alt == 0) av[m][bj] = *(const u32x4*)(ga + off); }
#pragma unroll
            for (int m = 0; m < 4; ++m)
#pragma unroll
                for (int bj = 0; bj < 2; ++bj) { f32x4 b0, b1; unpack8(bv[m][bj], b0, b1);
                    if (u.alt == 0) { f32x4 a0, a1; unpack8(av[m][bj], a0, a1);
#pragma unroll
                        for (int r = 0; r < 4; ++r) { acc[ai][bj][m][0][r] *= (1.0f + __expf(-b0[r])) * __builtin_amdgcn_rcpf(1.0f + __expf(-a0[r]));
                                                      acc[ai][bj][m][1][r] *= (1.0f + __expf(-b1[r])) * __builtin_amdgcn_rcpf(1.0f + __expf(-a1[r])); } }
                    else *(u32x4*)(mixed + (size_t)(row0 + ai * 128 + m * 16) * 1024 + col0 + bj * 128) = pack8(acc[ai][bj][m][0] * sig4(b0), acc[ai][bj][m][1] * sig4(b1)); } }
    }
};
struct EpiRes {
    static constexpr bool PERM = true, HAS_PRE = false, PAIRS = false;
    bf16_t* hb; float sc; float* part; float* ssq;
    __device__ __forceinline__ void operator()(const Acc& acc, const Unit& u, int wr, int wc, int fr, int fq) const {
        asm volatile("" : "+v"(fr), "+v"(fq));
        const int row0 = u.pm * 256 + wr * 64 + fr, col0 = u.pn * 256 + wc * 32 + 8 * fq;
        if (u.split) {
            float* pt = part + (size_t)(u.split - 1) * 256 * DM;
#pragma unroll
            for (int ai = 0; ai < 2; ++ai)
#pragma unroll
                for (int m = 0; m < 4; ++m)
#pragma unroll
                    for (int bj = 0; bj < 2; ++bj)
#pragma unroll
                        for (int n = 0; n < 2; ++n) *(f32x4*)(pt + (size_t)(wr * 64 + fr + ai * 128 + m * 16) * DM + col0 + bj * 128 + n * 4) = acc[ai][bj][m][n] * sc;
            return; }
#pragma unroll
        for (int ai = 0; ai < 2; ++ai) {
            u32x4 hv[4][2];
#pragma unroll
            for (int m = 0; m < 4; ++m)
#pragma unroll
                for (int bj = 0; bj < 2; ++bj) hv[m][bj] = *(const u32x4*)(hb + (size_t)(row0 + ai * 128 + m * 16) * DM + col0 + bj * 128);
#pragma unroll
            for (int m = 0; m < 4; ++m) { const size_t row = (size_t)(row0 + ai * 128 + m * 16); float sq = 0.f;
#pragma unroll
                for (int bj = 0; bj < 2; ++bj) { f32x4 o0, o1; unpack8(hv[m][bj], o0, o1); o0 += acc[ai][bj][m][0] * sc; o1 += acc[ai][bj][m][1] * sc;
                    *(u32x4*)(hb + row * DM + col0 + bj * 128) = pack8(o0, o1);
                    sq += ((o0[0] * o0[0] + o0[1] * o0[1]) + (o0[2] * o0[2] + o0[3] * o0[3])) + ((o1[0] * o1[0] + o1[1] * o1[1]) + (o1[2] * o1[2] + o1[3] * o1[3])); }
                const int lane = fq * 16 + fr; sq += shx(sq, lane, 16); sq += shx(sq, lane, 32);
                if (fq == 0) ssq[row * 16 + u.pn * 4 + wc] = sq; } }
    }
};
struct EpiFF {
    static constexpr bool PERM = true, HAS_PRE = true, PAIRS = false;
    bf16_t* ff; const float* rsv;
    __device__ __forceinline__ void pre(RsPre& r, const Unit& u, int wr, int fr) const {
#pragma unroll
        for (int ai = 0; ai < 2; ++ai)
#pragma unroll
            for (int m = 0; m < 4; ++m) r.rs[ai][m] = rsv[u.pm * 256 + wr * 64 + fr + ai * 128 + m * 16]; }
    __device__ __forceinline__ void operator()(const Acc& acc, const Unit& u, int wr, int wc, int fr, int fq, const RsPre& pr) const {
        asm volatile("" : "+v"(fr), "+v"(fq));
        const int row0 = u.pm * 256 + wr * 64 + fr, col0 = u.pn * 128 + wc * 32 + 8 * fq;
        const float (&rs)[2][4] = pr.rs;
#pragma unroll
        for (int ai = 0; ai < 2; ++ai)
#pragma unroll
            for (int m = 0; m < 4; ++m) { f32x4 o[2];
#pragma unroll
                for (int n = 0; n < 2; ++n) { const f32x4 a1 = acc[ai][0][m][n] * rs[ai][m], a3 = acc[ai][1][m][n] * rs[ai][m];
                    o[n] = (f32x4){siluf_(a1[0]) * a3[0], siluf_(a1[1]) * a3[1], siluf_(a1[2]) * a3[2], siluf_(a1[3]) * a3[3]}; }
                *(u32x4*)(ff + (size_t)(row0 + ai * 128 + m * 16) * DFF + col0) = pack8(o[0], o[1]); }
    }
};

__device__ __forceinline__ void conv_tile(const float* src, int ldsrc, int scol0, int k0, bf16_t* dst, int drow0, int K, float* lds, const float* ks = nullptr) {
    const int t = otid();
#pragma unroll
    for (int i = 0; i < 2; ++i) { const int r = (t >> 4) + 32 * i, c4 = (t & 15) * 4;
        const f32x4 v = *(const f32x4*)(src + (size_t)(k0 + r) * ldsrc + scol0 + c4);
        lds[r * 65 + c4 + 0] = v[0]; lds[r * 65 + c4 + 1] = v[1]; lds[r * 65 + c4 + 2] = v[2]; lds[r * 65 + c4 + 3] = v[3]; }
    __syncthreads();
    { const int n = t >> 3, kc = (t & 7) * 8; float v[8];
#pragma unroll
      for (int j = 0; j < 8; ++j) v[j] = lds[(kc + j) * 65 + n];
      if (ks) {
#pragma unroll
          for (int j = 0; j < 8; ++j) v[j] *= ks[k0 + kc + j]; }
      u32x4 w; w.x = cvt_pk_bf16(v[0], v[1]); w.y = cvt_pk_bf16(v[2], v[3]); w.z = cvt_pk_bf16(v[4], v[5]); w.w = cvt_pk_bf16(v[6], v[7]);
      *(u32x4*)(dst + (size_t)(drow0 + n) * K + k0 + kc) = w; }
    __syncthreads();
}
struct Sub4 { int scol[4], drow[4]; };
__device__ __forceinline__ void conv_tile4(const float* src, int ldsrc, const Sub4& sb, int k0, bf16_t* dst, int K, float* lds, const float* ks) {
    const int t = otid(); f32x4 v[4][2];
#pragma unroll
    for (int j = 0; j < 4; ++j)
#pragma unroll
        for (int i = 0; i < 2; ++i) v[j][i] = *(const f32x4*)(src + (size_t)(k0 + (t >> 4) + 32 * i) * ldsrc + sb.scol[j] + (t & 15) * 4);
    __syncthreads();
#pragma unroll
    for (int j = 0; j < 4; ++j)
#pragma unroll
        for (int i = 0; i < 2; ++i) { float* q = lds + j * 4160 + ((t >> 4) + 32 * i) * 65 + (t & 15) * 4; q[0] = v[j][i][0]; q[1] = v[j][i][1]; q[2] = v[j][i][2]; q[3] = v[j][i][3]; }
    __syncthreads();
    const int n = t >> 3, kc = (t & 7) * 8; float sc[8];
#pragma unroll
    for (int e = 0; e < 8; ++e) sc[e] = ks ? ks[k0 + kc + e] : 1.0f;
#pragma unroll
    for (int j = 0; j < 4; ++j) { float x[8];
#pragma unroll
        for (int e = 0; e < 8; ++e) x[e] = lds[j * 4160 + (kc + e) * 65 + n] * sc[e];
        u32x4 w; w.x = cvt_pk_bf16(x[0], x[1]); w.y = cvt_pk_bf16(x[2], x[3]); w.z = cvt_pk_bf16(x[4], x[5]); w.w = cvt_pk_bf16(x[6], x[7]);
        *(u32x4*)(dst + (size_t)(sb.drow[j] + n) * K + k0 + kc) = w; }
}
constexpr int NCONV_MIX = 256 + 64 + 16 + 32 + 32 + 64;
__device__ void conv_mixer_item(const Params& p, int l, int it, float* lds) {
    bf16_t* W = (bf16_t*)(p.ws + WS_W); Sub4 sb;
    if (it < 256) { const int kt = it & 15, nb = it >> 4;
#pragma unroll
        for (int j = 0; j < 4; ++j) { const int mycol = (nb < 8 ? nb * 256 : 2304 + (nb - 8) * 256) + j * 64; sb.drow[j] = mycol; sb.scol[j] = nb < 8 ? mycol : mycol - 240; }
        conv_tile4(p.w_in + (size_t)l * 1024 * 4112, 4112, sb, kt * 64, W + W_IN, 1024, lds, p.norm1 + (size_t)l * DM); return; }
    it -= 256;
    if (it < 64) {
        const int kb = it & 1, jb = it >> 1, k = kb * 512 + otid();
        const float* src = p.w_in + (size_t)l * 1024 * 4112 + (size_t)k * 4112 + 2048; float a[16];
#pragma unroll
        for (int q = 0; q < 4; ++q) { const f32x4 v = *(const f32x4*)(src + 4 * q); a[4 * q] = v[0]; a[4 * q + 1] = v[1]; a[4 * q + 2] = v[2]; a[4 * q + 3] = v[3]; }
        const float* wa = p.w_alpha + (size_t)l * 16 * 256; const float g1 = p.norm1[(size_t)l * DM + k];
        for (int jj = 0; jj < 8; ++jj) { const int j = jb * 8 + jj; float s = 0.f;
#pragma unroll
            for (int r = 0; r < 16; ++r) s += a[r] * wa[r * 256 + j];
            W[W_IN + (size_t)(C_GL + j) * 1024 + k] = f2bf(s * g1); }
        return; }
    it -= 64;
    const float* src; int ld, kt, nb, K; size_t wo;
    if (it < 16) { src = p.w_glu + (size_t)l * 512 * 512; ld = 512; kt = it & 7; nb = it >> 3; K = 512; wo = W_GLU; }
    else if ((it -= 16) < 32) { src = p.w_pa + (size_t)l * 512 * 1024; ld = 1024; kt = it & 7; nb = it >> 3; K = 512; wo = W_PA; }
    else if ((it -= 32) < 32) { src = p.w_pb + (size_t)l * 512 * 1024; ld = 1024; kt = it & 7; nb = it >> 3; K = 512; wo = W_PB; }
    else { it -= 32; src = p.w_out + (size_t)l * 1024 * 1024; ld = 1024; kt = it & 15; nb = it >> 4; K = 1024; wo = W_OUT; }
#pragma unroll
    for (int j = 0; j < 4; ++j) { sb.scol[j] = nb * 256 + j * 64; sb.drow[j] = nb * 256 + j * 64; }
    conv_tile4(src, ld, sb, kt * 64, W + wo, K, lds, nullptr);
}
constexpr int NCONV_FF = 3 * 176;
__device__ void conv_ff_item(const Params& p, int l, int it, float* lds) {
    bf16_t* W = (bf16_t*)(p.ws + WS_W); Sub4 sb;
    if (it < 352) { const int which = it >= 176; if (which) it -= 176;
        const int kt = it & 15, nb = it >> 4;
        const float* src = (which ? p.w_ff3 : p.w_ff1) + (size_t)l * 1024 * DFF;
#pragma unroll
        for (int j = 0; j < 4; ++j) { const int n0 = nb * 256 + j * 64; sb.scol[j] = n0; sb.drow[j] = (n0 >> 7) * 256 + (n0 & 127) + which * 128; }
        conv_tile4(src, DFF, sb, kt * 64, W + W_FF13, 1024, lds, p.norm2 + (size_t)l * DM); return; }
    it -= 352;
    { const int nb = it & 3, kt = it >> 2;
#pragma unroll
      for (int j = 0; j < 4; ++j) { sb.scol[j] = nb * 256 + j * 64; sb.drow[j] = nb * 256 + j * 64; }
      conv_tile4(p.w_ff2 + (size_t)l * DFF * 1024, 1024, sb, kt * 64, W + W_FF2, DFF, lds, nullptr); }
}

__device__ __forceinline__ void sincos_small(float x, float& sn, float& cs) {
    const float k = rintf(x * 0.636619772f);
    float r = fmaf(-k, 1.5703125f, x); r = fmaf(-k, 4.837512969970703125e-4f, r); r = fmaf(-k, 7.54978995489188216e-8f, r);
    const int q = ((int)k) & 3; const float r2 = r * r;
    const float sp = r + r * r2 * (-1.6666654611e-1f + r2 * (8.3321608736e-3f + r2 * (-1.9515295891e-4f)));
    const float cp = 1.0f - 0.5f * r2 + r2 * r2 * (4.166664568298827e-2f + r2 * (-1.388731625493765e-3f + r2 * 2.443315711809948e-5f));
    sn = (q == 0) ? sp : (q == 1) ? cp : (q == 2) ? -sp : -cp;
    cs = (q == 0) ? cp : (q == 1) ? -sp : (q == 2) ? -cp : sp;
}
__device__ void s5_prep_item(const Params& p, int l, int gi, float* lds) {
    const int g = gi >> 3, part = gi & 7;
    __syncthreads();
    float* ap_re = lds;
    float* ap_im = ap_re + 17 * 64;
    float* bb_re = ap_im + 17 * 64;
    float* bb_im = bb_re + 1024;
    float* cc_re = bb_im + 1024;
    float* cc_im = cc_re + 1024;
    float* Kd = cc_im + 1024;
    const int t = otid();
    const size_t lg = (size_t)l * 32 + g;
    if (t < 64) { const int pp = t;
        const float step = expf(p.log_step[lg]);
        const float lr = fminf(p.lam_re[lg * 64 + pp], -1e-4f), li = p.lam_im[lg * 64 + pp];
        const float mag = expf(lr * step); float sn, cs; sincos_small(li * step, sn, cs);
        const float abr = mag * cs, abi = mag * sn;
        float pr = 1.f, pi = 0.f;
        for (int d = 0; d <= 16; ++d) { ap_re[d * 64 + pp] = pr; ap_im[d * 64 + pp] = pi; const float nr_ = pr * abr - pi * abi, ni_ = pr * abi + pi * abr; pr = nr_; pi = ni_; }
        const float den = lr * lr + li * li, nr = abr - 1.0f, cr = (nr * lr + abi * li) / den, ci = (abi * lr - nr * li) / den;
        for (int h = 0; h < 16; ++h) { const float br = p.b_re[(lg * 64 + pp) * 16 + h], bi = p.b_im[(lg * 64 + pp) * 16 + h];
            bb_re[pp * 16 + h] = cr * br - ci * bi; bb_im[pp * 16 + h] = cr * bi + ci * br; }
        if (part == 0) { float* a16 = (float*)(p.ws + WS_A16) + (g * 64 + pp) * 2; a16[0] = ap_re[16 * 64 + pp]; a16[1] = ap_im[16 * 64 + pp]; }
    }
    for (int i = t; i < 1024; i += 512) { cc_re[i] = p.c_re[lg * 1024 + i]; cc_im[i] = p.c_im[lg * 1024 + i]; }
    __syncthreads();
    for (int i3 = t; i3 < 768; i3 += 512) { const int d = 2 * part - 1 + (i3 >> 8); if (d < 0) continue;
        const int idx = (d << 8) + (i3 & 255), h = (idx >> 4) & 15, h2 = idx & 15; float s = 0.f;
        for (int pp = 0; pp < 64; ++pp) { const float cr = cc_re[h * 64 + pp], ci = cc_im[h * 64 + pp], ar = ap_re[d * 64 + pp], ai = ap_im[d * 64 + pp];
            const float gr = cr * ar - ci * ai, gi = cr * ai + ci * ar; s += gr * bb_re[pp * 16 + h2] - gi * bb_im[pp * 16 + h2]; }
        Kd[idx] = s; }
    __syncthreads();
    bf16_t* Wy = (bf16_t*)(p.ws + WS_WY) + (size_t)g * 256 * 384;
    for (int i2 = part * 4096 + t; i2 < (part + 1) * 4096; i2 += 512) { const int n = i2 >> 7, kk = i2 & 127, j = n >> 4, h = n & 15, pp = kk & 63, im = kk >> 6;
        const float cr = cc_re[h * 64 + pp], ci = cc_im[h * 64 + pp], ar = ap_re[(j + 1) * 64 + pp], ai = ap_im[(j + 1) * 64 + pp];
        Wy[(size_t)n * 384 + 256 + kk] = f2bf(im ? -(cr * ai + ci * ar) : (cr * ar - ci * ai)); }
    bf16_t* Tz = (bf16_t*)(p.ws + WS_TZ) + (size_t)g * 16 * 512;
    for (int idx = part * 1024 + t; idx < (part + 1) * 1024; idx += 512) { const int d = idx >> 9, h = (idx >> 5) & 15, kk = idx & 31, sl = kk >> 4, h2 = kk & 15, lag = d - sl;
        Tz[idx] = f2bf(lag >= 0 ? Kd[(lag << 8) + (h << 4) + h2] : 0.f); }
    bf16_t* We = (bf16_t*)(p.ws + WS_WE) + (size_t)g * 128 * 256;
    for (int idx = part * 4096 + t; idx < (part + 1) * 4096; idx += 512) { const int n = idx >> 8, k = idx & 255, pp = n & 63, im = n >> 6, s = k >> 4, h2 = k & 15;
        const float ar = ap_re[(15 - s) * 64 + pp], ai = ap_im[(15 - s) * 64 + pp], br = bb_re[pp * 16 + h2], bi = bb_im[pp * 16 + h2];
        We[idx] = f2bf(im ? (ar * bi + ai * br) : (ar * br - ai * bi)); }
    __syncthreads();
}

__device__ __forceinline__ float wave_sum(float v, int lane) {
#pragma unroll
    for (int o = 32; o >= 1; o >>= 1) v += shx(v, lane, o);
    return v;
}
__device__ void rmsnorm_rows(const Params& p, float* h, const float* gain, bf16_t* z, int nslice) {
    const int t_ = otid(), wave = t_ >> 6, lane = t_ & 63;
    f32x4 gv[4];
#pragma unroll
    for (int i = 0; i < 4; ++i) gv[i] = *(const f32x4*)(gain + lane * 4 + 256 * i);
    for (int row0 = p.bid * 16 + wave * 2; row0 < MP; row0 += p.nblk * 16) {
        f32x4 v[2][4];
#pragma unroll
        for (int rr = 0; rr < 2; ++rr)
#pragma unroll
            for (int i = 0; i < 4; ++i) v[rr][i] = *(const f32x4*)(h + (size_t)(row0 + rr) * DM + lane * 4 + 256 * i);
#pragma unroll
        for (int rr = 0; rr < 2; ++rr) { const int row = row0 + rr; float* hp = h + (size_t)row * DM; float ss = 0.f;
            if (row >= MP - 256 && nslice > 0) {
                const float* pt = (const float*)(p.ws + WS_PART) + (size_t)(row - (MP - 256)) * DM + lane * 4;
                for (int sl = 0; sl < nslice; ++sl)
#pragma unroll
                    for (int i = 0; i < 4; ++i) v[rr][i] += *(const f32x4*)(pt + (size_t)sl * 256 * DM + 256 * i);
#pragma unroll
                for (int i = 0; i < 4; ++i) *(f32x4*)(hp + lane * 4 + 256 * i) = v[rr][i]; }
#pragma unroll
            for (int i = 0; i < 4; ++i) ss += v[rr][i][0] * v[rr][i][0] + v[rr][i][1] * v[rr][i][1] + v[rr][i][2] * v[rr][i][2] + v[rr][i][3] * v[rr][i][3];
            ss = wave_sum(ss, lane); const float rs = rsqrtf(ss * (1.0f / DM) + EPS);
#pragma unroll
            for (int i = 0; i < 4; ++i) { const f32x4 o = v[rr][i] * rs * gv[i]; u32x2 w; w.x = cvt_pk_bf16(o[0], o[1]); w.y = cvt_pk_bf16(o[2], o[3]);
                *(u32x2*)(z + (size_t)row * DM + lane * 4 + 256 * i) = w; } }
    }
}
__device__ void final_norm(const Params& p, const bf16_t* hb, const float* gain, float* out) {
    const int t_ = otid(), wave = t_ >> 6, lane = t_ & 63;
    f32x4 gv[4];
#pragma unroll
    for (int i = 0; i < 4; ++i) gv[i] = *(const f32x4*)(gain + lane * 4 + 256 * i);
    for (int orow = p.bid * 8 + wave; orow < NBATCH * SEQ; orow += p.nblk * 8) {
        const int b = orow >> 12, tt = orow & 4095, row = b * TB + NMETA + tt; const bf16_t* hp = hb + (size_t)row * DM; f32x4 v[4]; float ss = 0.f;
#pragma unroll
        for (int i = 0; i < 4; ++i) { const u32x2 w = *(const u32x2*)(hp + lane * 4 + 256 * i); v[i] = (f32x4){bflo(w.x), bfhi(w.x), bflo(w.y), bfhi(w.y)}; }
        if (row >= MP - 256) { const float* pt = (const float*)(p.ws + WS_PART) + (size_t)(row - (MP - 256)) * DM + lane * 4;
            for (int sl = 0; sl < 11; ++sl)
#pragma unroll
                for (int i = 0; i < 4; ++i) v[i] += *(const f32x4*)(pt + (size_t)sl * 256 * DM + 256 * i); }
#pragma unroll
        for (int i = 0; i < 4; ++i) ss += v[i][0] * v[i][0] + v[i][1] * v[i][1] + v[i][2] * v[i][2] + v[i][3] * v[i][3];
        ss = wave_sum(ss, lane); const float rs = rsqrtf(ss * (1.0f / DM) + EPS);
#pragma unroll
        for (int i = 0; i < 4; ++i) *(f32x4*)(out + (size_t)orow * DM + lane * 4 + 256 * i) = v[i] * rs * gv[i];
    }
}
__device__ void init_h(const Params& p) {
    bf16_t* hb = (bf16_t*)(p.ws + WS_H);
    const int t_ = otid(), wave = t_ >> 6, lane = t_ & 63;
    for (int row = p.bid * 8 + wave; row < MP; row += p.nblk * 8) {
        const int b = row / TB, r = row - b * TB; f32x4 v[4]; float ss = 0.f;
#pragma unroll
        for (int i = 0; i < 4; ++i) { const int c4 = lane * 4 + 256 * i; v[i] = (f32x4){0.f, 0.f, 0.f, 0.f};
            if (r < NMETA) v[i] = *(const f32x4*)(p.meta + (size_t)r * DM + c4);
            else if (r < NMETA + SEQ) v[i] = *(const f32x4*)(p.x + ((size_t)b * SEQ + (r - NMETA)) * DM + c4);
            u32x2 w; w.x = cvt_pk_bf16(v[i][0], v[i][1]); w.y = cvt_pk_bf16(v[i][2], v[i][3]); *(u32x2*)(hb + (size_t)row * DM + c4) = w;
            ss += v[i][0] * v[i][0] + v[i][1] * v[i][1] + v[i][2] * v[i][2] + v[i][3] * v[i][3]; }
        ss = wave_sum(ss, lane);
        if (lane == 0) ((float*)(p.ws + WS_RS1))[row] = rsqrtf(ss * (1.0f / DM) + EPS);
    }
}
__device__ void fold_rows(const Params& p, int nslice, const float* ssq, float* rsv) {
    bf16_t* hb = (bf16_t*)(p.ws + WS_H);
    const int t_ = otid(), wave = t_ >> 6, lane = t_ & 63;
    for (int idx = p.bid * 8 + wave; idx < 256; idx += p.nblk * 8) {
        const int row = MP - 256 + idx; bf16_t* hp = hb + (size_t)row * DM; f32x4 v[4]; float ss = 0.f;
#pragma unroll
        for (int i = 0; i < 4; ++i) { const u32x2 w = *(const u32x2*)(hp + lane * 4 + 256 * i); v[i] = (f32x4){bflo(w.x), bfhi(w.x), bflo(w.y), bfhi(w.y)}; }
        const float* pt = (const float*)(p.ws + WS_PART) + (size_t)idx * DM + lane * 4;
        for (int s0 = 0; s0 < nslice; s0 += 4) {
            f32x4 tq[4][4];
#pragma unroll
            for (int q = 0; q < 4; ++q) { const int sl = s0 + q < nslice ? s0 + q : nslice - 1;
#pragma unroll
                for (int i = 0; i < 4; ++i) tq[q][i] = *(const f32x4*)(pt + (size_t)sl * 256 * DM + 256 * i); }
#pragma unroll
            for (int q = 0; q < 4; ++q) { const float on = s0 + q < nslice ? 1.f : 0.f;
#pragma unroll
                for (int i = 0; i < 4; ++i) v[i] += tq[q][i] * on; } }
#pragma unroll
        for (int i = 0; i < 4; ++i) { u32x2 w; w.x = cvt_pk_bf16(v[i][0], v[i][1]); w.y = cvt_pk_bf16(v[i][2], v[i][3]); *(u32x2*)(hp + lane * 4 + 256 * i) = w;
            ss += v[i][0] * v[i][0] + v[i][1] * v[i][1] + v[i][2] * v[i][2] + v[i][3] * v[i][3]; }
        ss = wave_sum(ss, lane);
        if (lane == 0) rsv[row] = rsqrtf(ss * (1.0f / DM) + EPS);
    }
    for (int row = p.bid * 512 + t_; row < MP - 256; row += p.nblk * 512) rsv[row] = row_rs(ssq, row);
}

constexpr int S5_ITEMS = 512;
__device__ void s5a_item(const Params& p, int item, LAS unsigned char* lds) {
    const int xcd_ = item & 7, slot_ = (item >> 3) & 31, g = xcd_ * 4 + (slot_ & 3), span = (item >> 8) * 8 + (slot_ >> 2), mt0 = span * 8, nmt = span == 15 ? 9 : 8;
    const int t = otid(), wave = t >> 6, lane = t & 63, fr = lane & 15, fq = lane >> 4;
    const bf16_t* proj = (const bf16_t*)(p.ws + WS_PROJ);
    const bf16_t* We = (const bf16_t*)(p.ws + WS_WE) + (size_t)g * 128 * 256;
    float* Xloc = (float*)(p.ws + WS_XLOC);
    u32x4 wf[8];
#pragma unroll
    for (int q = 0; q < 8; ++q) { const int i = t + 512 * q, r = i >> 5, c = i & 31; wf[q] = *(const u32x4*)(We + r * 256 + c * 8); }
    bf16x8 a[8];
    { const int mt = mt0 + wave;
#pragma unroll
      for (int ks = 0; ks < 8; ++ks) a[ks] = *(const bf16x8*)(proj + (size_t)((mt * 16 + fr) * 16 + 2 * ks + (fq >> 1)) * NPROJ + C_U + g * 16 + (fq & 1) * 8); }
    __syncthreads();
#pragma unroll
    for (int q = 0; q < 8; ++q) { const int i = t + 512 * q, r = i >> 5, c = i & 31; *(LAS u32x4*)(lds + r * 528 + c * 16) = wf[q]; }
    __syncthreads();
    for (int mt = mt0 + wave; mt < mt0 + nmt; mt += 8) {
        if (mt != mt0 + wave) {
#pragma unroll
            for (int ks = 0; ks < 8; ++ks) a[ks] = *(const bf16x8*)(proj + (size_t)((mt * 16 + fr) * 16 + 2 * ks + (fq >> 1)) * NPROJ + C_U + g * 16 + (fq & 1) * 8); }
#pragma unroll 1
        for (int nt = 0; nt < 8; ++nt) { f32x4 acc = (f32x4){0.f, 0.f, 0.f, 0.f};
#pragma unroll
            for (int ks = 0; ks < 8; ++ks) { const bf16x8 b = *(const LAS bf16x8*)(lds + (nt * 16 + fr) * 528 + (ks * 32 + fq * 8) * 2); acc = mfma16(b, a[ks], acc); }
            *(f32x4*)(Xloc + ((size_t)(mt * 16 + fr) * 32 + g) * 128 + nt * 16 + 4 * fq) = acc; }
    }
}
__device__ void s5_scan(const Params& p) {
    const int lane = otid() & 63;
    float* Xloc = (float*)(p.ws + WS_XLOC);
    const float* a16 = (const float*)(p.ws + WS_A16);
    for (int ci = p.bid; ci < 256; ci += p.nblk) {
        const int b = ci >> 5, g = ci & 31;
        const float ar = a16[(g * 64 + lane) * 2], ai = a16[(g * 64 + lane) * 2 + 1];
        float* base = Xloc + ((size_t)(b * 258) * 32 + g) * 128 + lane;
        float sr = 0.f, si = 0.f;
        for (int c0 = 0; c0 < 258; c0 += 43) { float xr[43], xi[43];
#pragma unroll
            for (int j = 0; j < 43; ++j) { xr[j] = base[(size_t)(c0 + j) * 4096]; xi[j] = base[(size_t)(c0 + j) * 4096 + 64]; }
#pragma unroll
            for (int j = 0; j < 43; ++j) { if (!p.dry) { base[(size_t)(c0 + j) * 4096] = sr; base[(size_t)(c0 + j) * 4096 + 64] = si; }
                const float nr = ar * sr - ai * si + xr[j], ni = ar * si + ai * sr + xi[j]; sr = nr; si = ni; } }
    }
}
__device__ void s5c_item(const Params& p, int l, int item, LAS unsigned char* lds) {
    const int xcd_ = item & 7, slot_ = (item >> 3) & 31, g = xcd_ * 4 + (slot_ & 3), span = (item >> 8) * 8 + (slot_ >> 2), mt0 = span * 8, nmt = span == 15 ? 9 : 8, iters = (nmt + 7) >> 3;
    const int t = otid(), wave = t >> 6, lane = t & 63, fr = lane & 15, fq = lane >> 4;
    bf16_t* proj = (bf16_t*)(p.ws + WS_PROJ);
    const bf16_t* Wy = (const bf16_t*)(p.ws + WS_WY) + (size_t)g * 256 * 384;
    const bf16_t* Tz = (const bf16_t*)(p.ws + WS_TZ) + (size_t)g * 16 * 512;
    const float* Xin = (const float*)(p.ws + WS_XLOC);
    const f32x4 dsk = *(const f32x4*)(p.d_skip + (size_t)l * 512 + g * 16 + 4 * fq);
    for (int it = 0; it < iters; ++it) {
        const int mt = mt0 + it * 8 + wave; const bool active = mt < mt0 + nmt;
        u32x4 omf[8];
#pragma unroll
        for (int q = 0; q < 8; ++q) { const int i = t + 512 * q, r = i >> 4, c = i & 15; omf[q] = *(const u32x4*)(Wy + (size_t)r * 384 + 256 + c * 8); }
        bf16x8 tf[16];
#pragma unroll
        for (int d = 0; d < 16; ++d) tf[d] = *(const bf16x8*)(Tz + d * 512 + fr * 32 + fq * 8);
        bf16x8 a[12];
        if (active) {
#pragma unroll
            for (int ks = 0; ks < 8; ++ks) a[ks] = *(const bf16x8*)(proj + (size_t)((mt * 16 + fr) * 16 + 2 * ks + (fq >> 1)) * NPROJ + C_U + g * 16 + (fq & 1) * 8);
#pragma unroll
            for (int kk = 0; kk < 4; ++kk) { const float* xp = Xin + ((size_t)(mt * 16 + fr) * 32 + g) * 128 + kk * 32 + fq * 8; const f32x4 x0 = *(const f32x4*)xp, x1 = *(const f32x4*)(xp + 4);
                const u32x4 w = pack8(x0, x1); a[8 + kk] = *(const bf16x8*)&w; }
        } else {
#pragma unroll
            for (int ks = 0; ks < 12; ++ks) a[ks] = (bf16x8){0, 0, 0, 0, 0, 0, 0, 0};
        }
        __syncthreads();
#pragma unroll
        for (int q = 0; q < 8; ++q) { const int i = t + 512 * q, r = i >> 4, c = i & 15; *(LAS u32x4*)(lds + r * 272 + c * 16) = omf[q]; }
        u32x2 uwv[16];
        if (active) {
#pragma unroll
            for (int j = 0; j < 16; ++j) uwv[j] = *(const u32x2*)(proj + (size_t)((mt * 16 + fr) * 16 + j) * NPROJ + C_U + g * 16 + 4 * fq);
        } else {
#pragma unroll
            for (int j = 0; j < 16; ++j) uwv[j] = (u32x2){0u, 0u};
        }
        __syncthreads();
        if (active) {
#pragma unroll
            for (int j = 0; j < 16; ++j) { f32x4 acc = (f32x4){0.f, 0.f, 0.f, 0.f};
#pragma unroll
                for (int ks = 0; ks < 8; ++ks) if (ks <= (j >> 1)) acc = mfma16(tf[j - 2 * ks], a[ks], acc);
#pragma unroll
                for (int kk = 0; kk < 4; ++kk) { const bf16x8 b = *(const LAS bf16x8*)(lds + (j * 16 + fr) * 272 + (kk * 32 + fq * 8) * 2); acc = mfma16(b, a[8 + kk], acc); }
                bf16_t* up = proj + (size_t)((mt * 16 + fr) * 16 + j) * NPROJ + C_U + g * 16 + 4 * fq;
                const u32x2 uw = uwv[j];
                const float y0 = acc[0] + dsk[0] * bflo(uw.x), y1 = acc[1] + dsk[1] * bfhi(uw.x), y2 = acc[2] + dsk[2] * bflo(uw.y), y3 = acc[3] + dsk[3] * bfhi(uw.y);
                u32x2 ow; ow.x = cvt_pk_bf16(gelu_tanh(y0), gelu_tanh(y1)); ow.y = cvt_pk_bf16(gelu_tanh(y2), gelu_tanh(y3));
                if (!p.dry) *(u32x2*)up = ow;
                __builtin_amdgcn_sched_barrier(0); }
        }
    }
}

constexpr int GLA_ITEMS = NBATCH * 4 * (GCH / 2);
constexpr int GL_QD = 0, GL_KI = 9216, GL_P = 18432, GL_VT = 27648, GL_SEG = 46080, GL_HALF = 47104;
struct GlaLoads { unsigned short xl[16], xk[16], xq[16], vv[4][8]; };
__device__ __forceinline__ void gla_issue_loads(GlaLoads& L, const bf16_t* proj, int b, int h, int n, int dk, int seg, int t4, bool want_q) {
#pragma unroll
    for (int i = 0; i < 16; ++i) { const int rb = n * 64 + seg * 16 + i, rc = rb < TB ? rb : TB - 1; const bf16_t* rp = proj + (size_t)(b * TB + rc) * NPROJ + h * 64 + dk;
        if (want_q) { L.xl[i] = __builtin_nontemporal_load(rp + C_GL); L.xk[i] = __builtin_nontemporal_load(rp + C_K); L.xq[i] = __builtin_nontemporal_load(rp + C_Q); }
        else { L.xl[i] = rp[C_GL]; L.xk[i] = rp[C_K]; } }
#pragma unroll
    for (int q = 0; q < 4; ++q) { const int task = t4 + 256 * q, dv = task & 127, rg = task >> 7;
#pragma unroll
        for (int j = 0; j < 8; ++j) { const int rb = n * 64 + rg * 8 + j, rc = rb < TB ? rb : TB - 1; { const bf16_t* vp = proj + (size_t)(b * TB + rc) * NPROJ + C_V + h * 128 + dv; L.vv[q][j] = want_q ? __builtin_nontemporal_load(vp) : *vp; } } }
}
__device__ __forceinline__ float gla_cumsum(const Params& p, int l, const GlaLoads& L, int h, int n, int dk, int seg, LAS unsigned char* hl, float (&bc)[16]) {
    const float ba = p.b_alpha[(size_t)l * 256 + h * 64 + dk]; float run = 0.f;
#pragma unroll
    for (int i = 0; i < 16; ++i) { const int rb = n * 64 + seg * 16 + i; const float la = rb < TB ? logsigmoidf_(bf2f(L.xl[i]) + ba) * (1.0f / 16.0f) : 0.f;
        run += la; bc[i] = run; }
    LAS float* segs = (LAS float*)(hl + GL_SEG);
    segs[seg * 64 + dk] = run;
    __syncthreads();
    float pre = 0.f, tot = 0.f;
#pragma unroll
    for (int s = 0; s < 4; ++s) { const float v = segs[s * 64 + dk]; tot += v; if (s < seg) pre += v; }
#pragma unroll
    for (int i = 0; i < 16; ++i) bc[i] += pre;
    return tot;
}
__device__ __forceinline__ void gla_store_vT(const GlaLoads& L, int n, int t4, LAS unsigned char* hl) {
#pragma unroll
    for (int q = 0; q < 4; ++q) { const int task = t4 + 256 * q, dv = task & 127, rg = task >> 7; unsigned v[8];
#pragma unroll
        for (int j = 0; j < 8; ++j) { const int rb = n * 64 + rg * 8 + j; v[j] = rb < TB ? (unsigned)L.vv[q][j] : 0u; }
        u32x4 w; w.x = v[0] | (v[1] << 16); w.y = v[2] | (v[3] << 16); w.z = v[4] | (v[5] << 16); w.w = v[6] | (v[7] << 16);
        *(LAS u32x4*)(hl + GL_VT + dv * 144 + rg * 16) = w; }
}
__device__ void gla1_item(const Params& p, int l, int item, LAS unsigned char* lds) {
    const int t = otid(), half = t >> 8, t4 = t & 255, wv = (t >> 6) & 3, lane = t & 63, fr = lane & 15, fq = lane >> 4;
    const int pair = item % (GCH / 2), bh = item / (GCH / 2), b = bh >> 2, h = bh & 3, n = pair * 2 + half;
    const bf16_t* proj = (const bf16_t*)(p.ws + WS_PROJ);
    LAS unsigned char* hl = lds + half * GL_HALF;
    const int dk = t4 & 63, seg = t4 >> 6;
    GlaLoads L; gla_issue_loads(L, proj, b, h, n, dk, seg, t4, false);
    __syncthreads();
    float bc[16];
    const float tot = gla_cumsum(p, l, L, h, n, dk, seg, hl, bc);
    { unsigned w[8];
#pragma unroll
      for (int i = 0; i < 16; i += 2) { const int rb = n * 64 + seg * 16 + i;
          const float k0 = rb < TB ? bf2f(L.xk[i]) * __expf(tot - bc[i]) : 0.f, k1 = rb + 1 < TB ? bf2f(L.xk[i + 1]) * __expf(tot - bc[i + 1]) : 0.f;
          w[i >> 1] = cvt_pk_bf16(k0, k1); }
      *(LAS u32x4*)(hl + GL_KI + dk * 144 + seg * 32) = (u32x4){w[0], w[1], w[2], w[3]};
      *(LAS u32x4*)(hl + GL_KI + dk * 144 + seg * 32 + 16) = (u32x4){w[4], w[5], w[6], w[7]}; }
    gla_store_vT(L, n, t4, hl);
    if (seg == 0) ((float*)(p.ws + WS_DECAY))[((size_t)bh * GCH + n) * 64 + dk] = __expf(tot);
    __syncthreads();
    bf16_t* kvT = (bf16_t*)((unsigned char*)p.out + OS_KVT) + ((size_t)bh * GCH + n) * 8192;
#pragma unroll
    for (int mt = 0; mt < 2; ++mt) { const int dv0 = wv * 32 + mt * 16;
        bf16x8 rf[2];
#pragma unroll
        for (int ks = 0; ks < 2; ++ks) rf[ks] = *(const LAS bf16x8*)(hl + GL_VT + (dv0 + fr) * 144 + (ks * 32 + fq * 8) * 2);
#pragma unroll
        for (int nt = 0; nt < 4; ++nt) { f32x4 acc = (f32x4){0.f, 0.f, 0.f, 0.f};
#pragma unroll
            for (int ks = 0; ks < 2; ++ks) { const bf16x8 cf = *(const LAS bf16x8*)(hl + GL_KI + (nt * 16 + fr) * 144 + (ks * 32 + fq * 8) * 2); acc = mfma16(cf, rf[ks], acc); }
            u32x2 w; w.x = cvt_pk_bf16(acc[0], acc[1]); w.y = cvt_pk_bf16(acc[2], acc[3]);
            *(u32x2*)(kvT + (dv0 + fr) * 64 + nt * 16 + 4 * fq) = w; } }
}
__device__ void gla_scan(const Params& p) {
    const int tt = otid() - 64;
    if (tt < 0 || tt >= 256) return;
    bf16_t* kvT = (bf16_t*)((unsigned char*)p.out + OS_KVT);
    const float* decay = (const float*)(p.ws + WS_DECAY);
    for (int blk = p.bid; blk < 256; blk += p.nblk) {
        const int qi = blk * 256 + tt, bh = qi >> 11, rem = qi & 2047, dv = rem >> 4, dkq = rem & 15;
        bf16_t* kp = kvT + (size_t)bh * GCH * 8192 + dv * 64 + dkq * 4; const float* dp = decay + (size_t)bh * GCH * 64 + dkq * 4;
        f32x4 S = (f32x4){0.f, 0.f, 0.f, 0.f};
        for (int n0 = 0; n0 < 65; n0 += 13) { u32x2 w[13]; f32x4 d[13];
#pragma unroll
            for (int j = 0; j < 13; ++j) { w[j] = *(const u32x2*)(kp + (size_t)(n0 + j) * 8192); d[j] = *(const f32x4*)(dp + (n0 + j) * 64); }
#pragma unroll
            for (int j = 0; j < 13; ++j) { u32x2 o; o.x = cvt_pk_bf16(S[0], S[1]); o.y = cvt_pk_bf16(S[2], S[3]); if (!p.dry) *(u32x2*)(kp + (size_t)(n0 + j) * 8192) = o;
                S = d[j] * S + (f32x4){bflo(w[j].x), bfhi(w[j].x), bflo(w[j].y), bfhi(w[j].y)}; } }
    }
}
__device__ void gla3_item(const Params& p, int l, int item, LAS unsigned char* lds) {
    const int t = otid(), half = t >> 8, t4 = t & 255, wv = (t >> 6) & 3, lane = t & 63, fr = lane & 15, fq = lane >> 4;
    const int pair = item % (GCH / 2), bh = item / (GCH / 2), b = bh >> 2, h = bh & 3, n = pair * 2 + half;
    bf16_t* proj = (bf16_t*)(p.ws + WS_PROJ);
    LAS unsigned char* hl = lds + half * GL_HALF;
    const int dk = t4 & 63, seg = t4 >> 6;
    GlaLoads L; gla_issue_loads(L, proj, b, h, n, dk, seg, t4, true);
    const bf16_t* spT = (const bf16_t*)((const unsigned char*)p.out + OS_KVT) + ((size_t)bh * GCH + n) * 8192;
    bf16x8 spf[8][2];
#pragma unroll
    for (int nt = 0; nt < 8; ++nt)
#pragma unroll
        for (int ks = 0; ks < 2; ++ks) spf[nt][ks] = *(const bf16x8*)(spT + (nt * 16 + fr) * 64 + ks * 32 + fq * 8);
    const int rb = n * 64 + wv * 16 + fr, rbc = rb < TB ? rb : TB - 1;
    bf16_t* rowp = proj + (size_t)(b * TB + rbc) * NPROJ;
    u32x2 rwv[8];
#pragma unroll
    for (int nt = 0; nt < 8; ++nt) rwv[nt] = __builtin_nontemporal_load((const u32x2*)(rowp + C_R + h * 128 + nt * 16 + 4 * fq));
    __syncthreads();
    float bc[16];
    (void)gla_cumsum(p, l, L, h, n, dk, seg, hl, bc);
#pragma unroll
    for (int i = 0; i < 16; ++i) { const int rbi = n * 64 + seg * 16 + i, row = seg * 16 + i;
        const float qv = rbi < TB ? bf2f(L.xq[i]) * 0.125f * __expf(bc[i]) : 0.f, kv = rbi < TB ? bf2f(L.xk[i]) * __expf(-bc[i]) : 0.f;
        *(LAS bf16_t*)(hl + GL_QD + row * 144 + dk * 2) = f2bf(qv); *(LAS bf16_t*)(hl + GL_KI + row * 144 + dk * 2) = f2bf(kv); }
    gla_store_vT(L, n, t4, hl);
    __syncthreads();
    bf16x8 qf[2];
#pragma unroll
    for (int ks = 0; ks < 2; ++ks) qf[ks] = *(const LAS bf16x8*)(hl + GL_QD + (wv * 16 + fr) * 144 + (ks * 32 + fq * 8) * 2);
#pragma unroll
    for (int st = 0; st < 4; ++st) { f32x4 acc = (f32x4){0.f, 0.f, 0.f, 0.f};
        if (st <= wv) {
#pragma unroll
            for (int ks = 0; ks < 2; ++ks) { const bf16x8 cf = *(const LAS bf16x8*)(hl + GL_KI + (st * 16 + fr) * 144 + (ks * 32 + fq * 8) * 2); acc = mfma16(cf, qf[ks], acc); }
            const int c = wv * 16 + fr, s0 = st * 16 + 4 * fq;
#pragma unroll
            for (int r = 0; r < 4; ++r) if (s0 + r > c) acc[r] = 0.f;
        }
        u32x2 w; w.x = cvt_pk_bf16(acc[0], acc[1]); w.y = cvt_pk_bf16(acc[2], acc[3]);
        *(LAS u32x2*)(hl + GL_P + (wv * 16 + fr) * 144 + (st * 16 + 4 * fq) * 2) = w; }
    __syncthreads();
    bf16x8 pf[2];
#pragma unroll
    for (int ks = 0; ks < 2; ++ks) pf[ks] = *(const LAS bf16x8*)(hl + GL_P + (wv * 16 + fr) * 144 + (ks * 32 + fq * 8) * 2);
    f32x4 o[8]; float ss = 0.f;
#pragma unroll
    for (int nt = 0; nt < 8; ++nt) { f32x4 acc = (f32x4){0.f, 0.f, 0.f, 0.f};
#pragma unroll
        for (int ks = 0; ks < 2; ++ks) { const bf16x8 cf = *(const LAS bf16x8*)(hl + GL_VT + (nt * 16 + fr) * 144 + (ks * 32 + fq * 8) * 2); acc = mfma16(cf, pf[ks], acc); }
#if !MK_NO_INTER
#pragma unroll
        for (int ks = 0; ks < 2; ++ks) acc = mfma16(spf[nt][ks], qf[ks], acc);
#endif
        o[nt] = acc; ss += acc[0] * acc[0] + acc[1] * acc[1] + acc[2] * acc[2] + acc[3] * acc[3]; }
    ss += shx(ss, lane, 16); ss += shx(ss, lane, 32);
    const float rstd = rsqrtf(ss * (1.0f / 128.0f) + EPS);
    if (rb < TB) { const float* gn = p.gla_norm + (size_t)l * 512 + h * 128;
#pragma unroll
        for (int nt = 0; nt < 8; ++nt) { const int dv = nt * 16 + 4 * fq; const f32x4 gv = *(const f32x4*)(gn + dv); const u32x2 rw = rwv[nt];
            const float v0 = o[nt][0] * rstd * gv[0] * siluf_(bflo(rw.x)), v1 = o[nt][1] * rstd * gv[1] * siluf_(bfhi(rw.x)),
                        v2 = o[nt][2] * rstd * gv[2] * siluf_(bflo(rw.y)), v3 = o[nt][3] * rstd * gv[3] * siluf_(bfhi(rw.y));
            u32x2 w; w.x = cvt_pk_bf16(v0, v1); w.y = cvt_pk_bf16(v2, v3); if (!p.dry) *(u32x2*)(rowp + C_V + h * 128 + dv) = w; } }
}

__device__ __forceinline__ int mix_item(int r, int bid, int nblk) {
    const int pos = r * nblk + ((r & 1) ? nblk - 1 - bid : bid);
    if (pos >= S5_ITEMS + GLA_ITEMS) return -1;
    if (pos < 32) return 480 + pos;
    if (pos < S5_ITEMS) return pos - 32;
    return pos;
}
__device__ void tail_glu(const Params& p, int l, LAS unsigned char* lds) {
    const int t = otid(), w = t >> 6, lane = t & 63, fr = lane & 15, fq = lane >> 4, nt = w & 1, kq = w >> 1;
    bf16_t* proj = (bf16_t*)(p.ws + WS_PROJ); const bf16_t* Bt = (const bf16_t*)(p.ws + WS_W) + W_GLU;
    for (int piece = p.bid; piece < 256; piece += p.nblk) {
        const int row = MP - 256 + (piece >> 4) * 16 + fr, colw = (piece & 15) * 32 + nt * 16;
        bf16x8 a[4], b[4];
#pragma unroll
        for (int ks = 0; ks < 4; ++ks) { a[ks] = *(const bf16x8*)(proj + (size_t)row * NPROJ + C_U + kq * 128 + ks * 32 + fq * 8); b[ks] = *(const bf16x8*)(Bt + (size_t)(colw + fr) * 512 + kq * 128 + ks * 32 + fq * 8); }
        const int col = colw + 4 * fq;
        const u32x2 aw = *(const u32x2*)(proj + (size_t)row * NPROJ + C_U + col); const f32x4 bias = *(const f32x4*)(p.b_glu + (size_t)l * 512 + col);
        f32x4 acc = (f32x4){0.f, 0.f, 0.f, 0.f};
#pragma unroll
        for (int ks = 0; ks < 4; ++ks) acc = mfma16(b[ks], a[ks], acc);
        __syncthreads();
        *(LAS f32x4*)(lds + (w * 64 + lane) * 16) = acc;
        __syncthreads();
        if (w < 2) { f32x4 s = acc;
#pragma unroll
            for (int q = 1; q < 4; ++q) s += *(const LAS f32x4*)(lds + ((nt + 2 * q) * 64 + lane) * 16);
            const f32x4 act = (f32x4){bflo(aw.x), bfhi(aw.x), bflo(aw.y), bfhi(aw.y)}, o = act * sig4(s + bias);
            u32x2 ow; ow.x = cvt_pk_bf16(o[0], o[1]); ow.y = cvt_pk_bf16(o[2], o[3]); *(u32x2*)(proj + (size_t)row * NPROJ + C_GLU + col) = ow; }
    }
    __syncthreads();
}
__device__ void tail_mix(const Params& p, LAS unsigned char* lds) {
    const int t = otid(), w = t >> 6, lane = t & 63, fr = lane & 15, fq = lane >> 4, nt = w & 3, which = w >> 2;
    const bf16_t* proj = (const bf16_t*)(p.ws + WS_PROJ); const bf16_t* Bt = (const bf16_t*)(p.ws + WS_W) + (which ? W_PB : W_PA);
    bf16_t* mixed = (bf16_t*)((unsigned char*)p.out + OS_Z);
    for (int piece = p.bid; piece < 256; piece += p.nblk) {
        const int row = MP - 256 + (piece >> 4) * 16 + fr, colw = (piece & 15) * 64 + nt * 16, col = colw + 4 * fq;
        const bf16_t* ap = proj + (size_t)row * NPROJ + (which ? C_V : C_GLU); const bf16_t* bp = Bt + (size_t)(colw + fr) * 512;
        const u32x2 gaw = *(const u32x2*)(proj + (size_t)row * NPROJ + C_GA + col), gbw = *(const u32x2*)(proj + (size_t)row * NPROJ + C_GB + col);
        f32x4 acc = (f32x4){0.f, 0.f, 0.f, 0.f};
#pragma unroll
        for (int half = 0; half < 2; ++half) { bf16x8 a[8], b[8];
#pragma unroll
            for (int ks = 0; ks < 8; ++ks) { a[ks] = *(const bf16x8*)(ap + half * 256 + ks * 32 + fq * 8); b[ks] = *(const bf16x8*)(bp + half * 256 + ks * 32 + fq * 8); }
#pragma unroll
            for (int ks = 0; ks < 8; ++ks) acc = mfma16(b[ks], a[ks], acc); }
        __syncthreads();
        if (which) *(LAS f32x4*)(lds + (nt * 64 + lane) * 16) = acc;
        __syncthreads();
        if (!which) { const f32x4 accb = *(const LAS f32x4*)(lds + (nt * 64 + lane) * 16);
            const f32x4 ga = (f32x4){bflo(gaw.x), bfhi(gaw.x), bflo(gaw.y), bfhi(gaw.y)}, gb = (f32x4){bflo(gbw.x), bfhi(gbw.x), bflo(gbw.y), bfhi(gbw.y)};
            const f32x4 o = acc * sig4(ga) + accb * sig4(gb);
            u32x2 ow; ow.x = cvt_pk_bf16(o[0], o[1]); ow.y = cvt_pk_bf16(o[2], o[3]); *(u32x2*)(mixed + (size_t)row * DM + col) = ow; }
    }
    __syncthreads();
}

#define XB_TMO      128
#define XB_XCNT(j)  (256  + 64 * (j))
#define XB_XSUB(j)  (1280 + 64 * (j))
#define XB_XGEN(j)  (2304 + 64 * (j))
#define XB_TOP      3328
#define XB_TOPGEN   3392
#define XCD_BAR_WORDS 3456
#define XB_SPIN_CAP (1u << 20)
__device__ __forceinline__ unsigned xb_ld(unsigned* p)              { return __hip_atomic_load(p, __ATOMIC_RELAXED, __HIP_MEMORY_SCOPE_AGENT); }
__device__ __forceinline__ unsigned xb_add(unsigned* p, unsigned v) { return __hip_atomic_fetch_add(p, v, __ATOMIC_RELAXED, __HIP_MEMORY_SCOPE_AGENT); }
__device__ __forceinline__ unsigned xb_xcc_id() { return (unsigned)__builtin_amdgcn_s_getreg((3 << 11) | 20) & 0xFu; }
#define XB_SPIN(cond, bar) do { unsigned _sp = 0; while (cond) { __builtin_amdgcn_s_sleep(1); \
    if ((++_sp & 255u) == 0u) { if (xb_ld(&(bar)[XB_TMO])) break; if (_sp > XB_SPIN_CAP) { atomicAdd(&(bar)[XB_TMO], 1u); break; } } } } while (0)
struct XcdBarrier { unsigned* bar; unsigned x; volatile LAS unsigned* st; };
__device__ __forceinline__ XcdBarrier xcd_barrier_post(unsigned* bar, volatile LAS unsigned* st) {
    XcdBarrier b; b.bar = bar; b.x = xb_xcc_id(); b.st = st;
    if (threadIdx.x == 0) (void)xb_add(&bar[XB_XCNT(b.x)], 1u);
    return b;
}
__device__ __forceinline__ void xcd_barrier_complete(unsigned* bar, unsigned x, unsigned& nloc, unsigned& nx) {
    const unsigned G = gridDim.x * gridDim.y * gridDim.z;
    unsigned sum, cnt, mine, sp = 0u;
    for (;;) {
        sum = 0u; cnt = 0u; mine = 0u;
#pragma unroll
        for (unsigned j = 0; j < 16; ++j) { const unsigned c = xb_ld(&bar[XB_XCNT(j)]); sum += c; cnt += (c > 0u) ? 1u : 0u; mine = (j == x) ? c : mine; }
        if (sum == G) break;
        __builtin_amdgcn_s_sleep(1);
        if ((++sp & 255u) == 0u) { if (xb_ld(&bar[XB_TMO])) break; if (sp > XB_SPIN_CAP) { atomicAdd(&bar[XB_TMO], 1u); break; } }
    }
    nloc = mine > 0u ? mine : 1u; nx = cnt > 0u ? cnt : 1u;
}
__device__ __forceinline__ void xcd_barrier(const XcdBarrier& b) {
    asm volatile("s_waitcnt vmcnt(0)" ::: "memory");
    __syncthreads();
    if (threadIdx.x == 0) {
        unsigned* bar = b.bar;
        __builtin_amdgcn_s_waitcnt(0);
        unsigned nloc = b.st[0], nx = b.st[1];
        if (nloc == 0u) { xcd_barrier_complete(bar, b.x, nloc, nx); b.st[0] = nloc; b.st[1] = nx; }
        const unsigned old = xb_add(&bar[XB_XSUB(b.x)], 1u);
        const unsigned gen = old / nloc;
        if (old + 1u == (gen + 1u) * nloc) {
            __builtin_amdgcn_fence(__ATOMIC_RELEASE, "agent");
            asm volatile("s_waitcnt vmcnt(0)" ::: "memory");
            const unsigned og = xb_add(&bar[XB_TOP], 1u);
            const unsigned tg = og / nx;
            if (og + 1u == (tg + 1u) * nx) xb_add(&bar[XB_TOPGEN], 1u);
            else XB_SPIN(xb_ld(&bar[XB_TOPGEN]) == tg, bar);
            __builtin_amdgcn_fence(__ATOMIC_ACQUIRE, "agent");
            xb_add(&bar[XB_XGEN(b.x)], 1u);
            asm volatile("s_waitcnt vmcnt(0)" ::: "memory");
        } else {
            XB_SPIN(xb_ld(&bar[XB_XGEN(b.x)]) == gen, bar);
            __builtin_amdgcn_fence(__ATOMIC_ACQUIRE, "agent");
            asm volatile("s_waitcnt vmcnt(0)" ::: "memory");
        }
    }
    __syncthreads();
}

constexpr int NPHASE = 2 + 11 * DEPTH;
__device__ void run_phase(const Params& p, int ph, LAS unsigned char* lds) {
    bf16_t* hres = (bf16_t*)(p.ws + WS_H);
    bf16_t* proj = (bf16_t*)(p.ws + WS_PROJ);
    bf16_t* W = (bf16_t*)(p.ws + WS_W);
    bf16_t* z = (bf16_t*)((unsigned char*)p.out + OS_Z);
    bf16_t* hy = (bf16_t*)(p.ws + WS_Y);
    float* ssq1 = (float*)(p.ws + WS_SSQ1); float* ssq2 = (float*)(p.ws + WS_SSQ2); float* rs1 = (float*)(p.ws + WS_RS1); float* rs2 = (float*)(p.ws + WS_RS2);
    float* ldsf = (float*)(unsigned char*)lds;
    pg8::StaticOrder S;
    if (ph == 0) {
        for (int it = p.bid; it < NCONV_MIX + 256; it += p.nblk) { if (it < NCONV_MIX) conv_mixer_item(p, 0, it, ldsf); else s5_prep_item(p, 0, it - NCONV_MIX, ldsf); }
        init_h(p); return; }
    if (ph == NPHASE - 1) { final_norm(p, hres, p.norm_f, p.out); return; }
    const int l = (ph - 1) / 11, s = (ph - 1) % 11;
    if (l >= MK_LAYERS || s > MK_LAST_S) return;
    switch (s) {
    case 0:
        if (l > 0) fold_rows(p, 11, ssq1, rs1);
        break;
    case 1: { S.init(MP, NPROJ, 1024, p.nblk, p.bid); pg8::gemm_phase(lds, pg8::Gemm{hres, W + W_IN, MP, NPROJ, 1024, 1024, nullptr, nullptr}, S, EpiStore{proj, NPROJ, rs1}); }
        { const int first = (MP / 256 * (NPROJ / 256)) % p.nblk;
          if (p.bid >= first && first > 0) for (int it = p.bid - first; it < 352; it += p.nblk - first) conv_ff_item(p, l, it, ldsf); else if (first == 0) for (int it = p.bid; it < 352; it += p.nblk) conv_ff_item(p, l, it, ldsf); }
        break;
    case 2:
        for (int it = p.bid; it < S5_ITEMS + GLA_ITEMS; it += p.nblk) { if (it < S5_ITEMS) s5a_item(p, it, lds); else gla1_item(p, l, it - S5_ITEMS, lds); }
        break;
    case 3:
        if (otid() < 64) s5_scan(p);
#if !MK_NO_GSCAN
        else gla_scan(p);
#endif
        break;
    case 4:
        for (int it = p.bid; it < S5_ITEMS + GLA_ITEMS; it += p.nblk) { if (it < S5_ITEMS) s5c_item(p, l, it, lds); else gla3_item(p, l, it - S5_ITEMS, lds); }
        break;
    case 5: { tail_glu(p, l, lds); S.init(MP - 256, 512, 512, p.nblk, p.bid); pg8::gemm_phase(lds, pg8::Gemm{proj + C_U, W + W_GLU, MP - 256, 512, 512, NPROJ, nullptr, nullptr}, S, EpiGlu{proj, p.b_glu + (size_t)l * 512}); }
        if (l + 1 < DEPTH) for (int it = p.bid; it < 256; it += p.nblk) s5_prep_item(p, l + 1, it, ldsf);
        break;
    case 6: { tail_mix(p, lds); S.init(MP - 256, 1024, 512, p.nblk, p.bid, 0, 1);
        pg8::gemm_phase(lds, pg8::Gemm{proj + C_GLU, W + W_PA, MP - 256, 1024, 512, NPROJ, proj + C_V, W + W_PB}, S, EpiMixPair{proj + C_GA, proj + C_GB, z}); } break;
    case 7: { S.init(MP, 1024, 1024, p.nblk, p.bid, 4); pg8::gemm_phase(lds, pg8::Gemm{z, W + W_OUT, MP, 1024, 1024, 1024, nullptr, nullptr}, S, EpiRes{hres, p.dry ? 0.f : 1.f, (float*)(p.ws + WS_PART), ssq2}); }
        break;
    case 8:
        fold_rows(p, 4, ssq2, rs2); break;
    case 9: { S.init(MP, 2 * DFF, 1024, p.nblk, p.bid); pg8::gemm_phase(lds, pg8::Gemm{hres, W + W_FF13, MP, 2 * DFF, 1024, 1024, nullptr, nullptr}, S, EpiFF{proj, rs2}); }
        { const int first = (MP / 256 * (2 * DFF / 256)) % p.nblk, nmix = l + 1 < DEPTH ? NCONV_MIX : 0;
          const int i0 = first > 0 ? p.bid - first : p.bid, st = first > 0 ? p.nblk - first : p.nblk;
          if (i0 >= 0) for (int it = i0; it < nmix + 176; it += st) { if (it < nmix) conv_mixer_item(p, l + 1, it, ldsf); else conv_ff_item(p, l, 352 + it - nmix, ldsf); } }
        break;
    case 10: { S.init(MP, 1024, DFF, p.nblk, p.bid, 11); pg8::gemm_phase(lds, pg8::Gemm{proj, W + W_FF2, MP, 1024, DFF, DFF, nullptr, nullptr}, S, EpiRes{hres, p.dry ? 0.f : 1.f, (float*)(p.ws + WS_PART), ssq1}); }
        break;
    }
}

typedef const float* fptr_t;
typedef __attribute__((address_space(4))) const fptr_t kfptr_t;
__global__ void __launch_bounds__(512, 2) hybrid_fwd(Params p0) {
    extern __shared__ __attribute__((aligned(16))) unsigned char shm[];
    LAS unsigned char* lds = (LAS unsigned char*)shm;
    cg::grid_group grid = cg::this_grid();
    const int ph_lo = p0.ph_lo, ph_hi = p0.ph_hi;
    volatile LAS unsigned* xst = (volatile LAS unsigned*)(lds + 131072);
    if (threadIdx.x == 0) { xst[0] = 0u; xst[1] = 0u; }
    __syncthreads();
    XcdBarrier xb = xcd_barrier_post((unsigned*)(p0.ws + WS_BAR), xst);
    for (int ph = ph_lo; ph < ph_hi; ++ph) {
        if (ph == 1 && MK_ONE_LAUNCH) continue;
        int reps = (MK_DUP >= 0 && ph >= 1 && ph < NPHASE - 1 && (ph - 1) % 11 == MK_DUP) ? 2 : 1;
        for (int rep = 0; rep < reps; ++rep) {
        kfptr_t* tab = (kfptr_t*)__builtin_amdgcn_kernarg_segment_ptr(); asm volatile("" : "+s"(tab));
        Params p;
        p.x = tab[0]; p.meta = tab[1]; p.norm1 = tab[2]; p.w_in = tab[3]; p.lam_re = tab[4]; p.lam_im = tab[5]; p.log_step = tab[6]; p.b_re = tab[7]; p.b_im = tab[8];
        p.c_re = tab[9]; p.c_im = tab[10]; p.d_skip = tab[11]; p.w_glu = tab[12]; p.b_glu = tab[13]; p.w_pa = tab[14]; p.w_alpha = tab[15]; p.b_alpha = tab[16];
        p.gla_norm = tab[17]; p.w_pb = tab[18]; p.w_out = tab[19]; p.norm2 = tab[20]; p.w_ff1 = tab[21]; p.w_ff3 = tab[22]; p.w_ff2 = tab[23]; p.norm_f = tab[24];
        p.out = (float*)tab[25]; p.ws = (unsigned char*)tab[26]; p.ph_lo = ph_lo; p.ph_hi = ph_hi;
        int bid = blockIdx.x, nblk = gridDim.x; asm volatile("" : "+s"(bid)); asm volatile("" : "+s"(nblk));
        p.bid = bid; p.nblk = nblk; p.dry = (reps == 2 && rep == 0 && MK_DUP_DRY) ? 1 : 0; p.pad_ = 0;
        run_phase(p, ph, lds);
        if (rep + 1 < reps || ph + 1 < ph_hi) {
            if (ph == ph_lo && rep == 0) grid.sync();
            else { xb.bar = (unsigned*)(p.ws + WS_BAR); xcd_barrier(xb); } }
        if (MK_DUP == 99) { xb.bar = (unsigned*)(p.ws + WS_BAR); xcd_barrier(xb); }
        }
    }
}

extern "C" void kernel_launch(void* const* d_in, const int* in_sizes, int n_in, void* d_out, int out_size, void* d_ws, size_t ws_size, hipStream_t stream) {
    static int grid = 0;
    if (grid == 0) {
        if (n_in != 25 || ws_size < WS_END) { fprintf(stderr, "kernel_launch: unexpected n_in %d or ws_size %zu (< %zu)\n", n_in, ws_size, (size_t)WS_END); grid = -1; return; }
        int dev = 0, cus = 0, per_cu = 0;
        hipGetDevice(&dev); hipDeviceGetAttribute(&cus, hipDeviceAttributeMultiprocessorCount, dev);
        if (hipFuncSetAttribute((const void*)hybrid_fwd, hipFuncAttributeMaxDynamicSharedMemorySize, LDS_BYTES) != hipSuccess) { fprintf(stderr, "kernel_launch: hipFuncSetAttribute failed\n"); grid = -1; return; }
        if (hipOccupancyMaxActiveBlocksPerMultiprocessor(&per_cu, (const void*)hybrid_fwd, 512, LDS_BYTES) != hipSuccess || per_cu < 1) { fprintf(stderr, "kernel_launch: occupancy query says %d\n", per_cu); per_cu = 1; }
        (void)hipGetLastError();
        grid = cus * per_cu;
    }
    if (grid < 0) return;
    Params p{};
    const float** pp = (const float**)&p;
    for (int i = 0; i < 25; ++i) pp[i] = (const float*)d_in[i];
    p.out = (float*)d_out; p.ws = (unsigned char*)d_ws;
#if MK_ONE_LAUNCH
    p.ph_lo = 0; p.ph_hi = NPHASE;
    (void)hipMemsetAsync((char*)d_ws + WS_BAR, 0, 16384, stream);
    void* args[] = {&p};
    hipError_t e = hipLaunchCooperativeKernel((const void*)hybrid_fwd, dim3(grid), dim3(512), args, LDS_BYTES, stream);
    if (e != hipSuccess) fprintf(stderr, "cooperative launch failed: %s (grid %d)\n", hipGetErrorString(e), grid);
#else
    for (int ph = 0; ph < NPHASE; ++ph) { p.ph_lo = ph; p.ph_hi = ph + 1; hipLaunchKernelGGL(hybrid_fwd, dim3(grid), dim3(512), LDS_BYTES, stream, p); }
#endif
}
```

```cpp
#include <hip/hip_runtime.h>
#include <hip/hip_cooperative_groups.h>
#include <cstdio>
namespace cg = cooperative_groups;

#ifndef MK_DRY_S5ONLY
#define MK_DRY_S5ONLY 0
#endif
#ifndef MK_DUP_DRY
#define MK_DUP_DRY 0
#endif
#ifndef MK_DUP
#define MK_DUP -1
#endif
#ifndef MK_NO_GSCAN
#define MK_NO_GSCAN 0
#endif
#ifndef MK_NO_INTER
#define MK_NO_INTER 0
#endif
#ifndef MK_BRANCH
#define MK_BRANCH 0
#endif
#ifndef MK_LAYERS
#define MK_LAYERS 4
#endif
#ifndef MK_LAST_S
#define MK_LAST_S 10
#endif
#ifndef MK_ONE_LAUNCH
#define MK_ONE_LAUNCH 1
#endif

#define LAS __attribute__((address_space(3)))
typedef unsigned short bf16_t;
typedef short bf16x8 __attribute__((ext_vector_type(8)));
typedef float f32x4 __attribute__((ext_vector_type(4)));
typedef float f32x2 __attribute__((ext_vector_type(2)));
typedef unsigned u32x4 __attribute__((ext_vector_type(4)));
typedef unsigned u32x2 __attribute__((ext_vector_type(2)));

constexpr int DM = 1024, NBATCH = 8, SEQ = 4096, NMETA = 16, DEPTH = 4;
constexpr int TB = 4128;
constexpr int MP = NBATCH * TB;
constexpr int NPROJ = 4352;
constexpr int DFF = 2816;
constexpr int C_U = 0, C_Q = 512, C_K = 768, C_V = 1024, C_R = 1536, C_GL = 2048, C_GA = 2304, C_GB = 3328;
constexpr int C_GLU = 512;
constexpr int NCH16 = MP / 16;
constexpr int GCH = 66;
constexpr float EPS = 1e-6f;

constexpr size_t WS_H = 0;
constexpr size_t WS_PROJ = WS_H + (size_t)MP * DM * 4;
constexpr size_t WS_W = WS_PROJ + (size_t)MP * NPROJ * 2 + 65536;
constexpr size_t W_IN = 0, W_GLU = W_IN + (size_t)NPROJ * 1024, W_PA = W_GLU + 512 * 512, W_PB = W_PA + 1024 * 512, W_OUT = W_PB + 1024 * 512,
                 W_FF13 = W_OUT + 1024 * 1024, W_FF2 = W_FF13 + (size_t)2 * DFF * 1024, W_END = W_FF2 + (size_t)1024 * DFF;
constexpr size_t WS_XLOC = WS_W + W_END * 2;
constexpr size_t WS_WY = WS_XLOC + (size_t)NCH16 * 32 * 128 * 4;
constexpr size_t WS_WE = WS_WY + (size_t)32 * 256 * 384 * 2;
constexpr size_t WS_A16 = WS_WE + (size_t)32 * 128 * 256 * 2;
constexpr size_t WS_DECAY = WS_A16 + 32 * 64 * 2 * 4;
constexpr size_t WS_PART = WS_DECAY + (size_t)32 * GCH * 64 * 4;
constexpr size_t WS_BAR = WS_PART + (size_t)11 * 256 * 1024 * 4;
constexpr size_t WS_SSQ1 = WS_BAR + 16384;
constexpr size_t WS_SSQ2 = WS_SSQ1 + (size_t)MP * 16 * 4;
constexpr size_t WS_RS1 = WS_SSQ2 + (size_t)MP * 16 * 4;
constexpr size_t WS_RS2 = WS_RS1 + (size_t)MP * 4;
constexpr size_t WS_TZ = WS_RS2 + (size_t)MP * 4;
constexpr size_t WS_END = WS_TZ + (size_t)32 * 16 * 512 * 2;
constexpr size_t WS_Y = WS_PROJ + (size_t)MP * DFF * 2;
constexpr size_t OS_Z = 0;
constexpr size_t OS_KVT = (size_t)MP * DM * 2;
constexpr size_t OS_END = OS_KVT + (size_t)32 * GCH * 8192 * 2;
static_assert(OS_END <= (size_t)NBATCH * SEQ * DM * 4, "d_out scratch overflow");
static_assert(WS_END <= (size_t)512 * 1024 * 1024, "workspace overflow");

constexpr int LDS_BYTES = 131072 + 16;

struct Params {
    const float *x, *meta, *norm1, *w_in, *lam_re, *lam_im, *log_step, *b_re, *b_im, *c_re, *c_im, *d_skip, *w_glu, *b_glu, *w_pa, *w_alpha, *b_alpha,
        *gla_norm, *w_pb, *w_out, *norm2, *w_ff1, *w_ff3, *w_ff2, *norm_f;
    float* out; unsigned char* ws; int ph_lo, ph_hi, bid, nblk, dry, pad_;
};

__device__ __forceinline__ float bf2f(bf16_t b) { return __uint_as_float(((unsigned)b) << 16); }
__device__ __forceinline__ float bflo(unsigned w) { return __uint_as_float(w << 16); }
__device__ __forceinline__ float bfhi(unsigned w) { return __uint_as_float(w & 0xffff0000u); }
typedef __bf16 bf16n2 __attribute__((ext_vector_type(2)));
__device__ __forceinline__ unsigned cvt_pk_bf16(float lo, float hi) { const f32x2 f = {lo, hi}; const bf16n2 v = __builtin_convertvector(f, bf16n2); return __builtin_bit_cast(unsigned, v); }
__device__ __forceinline__ bf16_t f2bf(float f) { return (bf16_t)(cvt_pk_bf16(f, 0.f) & 0xffffu); }
__device__ __forceinline__ float sigmoidf_(float x) { return __builtin_amdgcn_rcpf(1.0f + __expf(-x)); }
__device__ __forceinline__ float siluf_(float x) { return x * sigmoidf_(x); }
__device__ __forceinline__ float logsigmoidf_(float x) { return fminf(x, 0.f) - __logf(1.0f + __expf(-fabsf(x))); }
__device__ __forceinline__ float gelu_tanh(float x) { const float u = 0.7978845608f * (x + 0.044715f * x * x * x); return x * sigmoidf_(2.f * u); }
__device__ __forceinline__ f32x4 mfma16(bf16x8 colfrag, bf16x8 rowfrag, f32x4 acc) { return __builtin_amdgcn_mfma_f32_16x16x32_bf16(colfrag, rowfrag, acc, 0, 0, 0); }
__device__ __forceinline__ int otid() { int t = threadIdx.x; asm volatile("" : "+v"(t)); return t; }
__device__ __forceinline__ float shx(float v, int lane, int o) { return __int_as_float(__builtin_amdgcn_ds_bpermute((lane ^ o) << 2, __float_as_int(v))); }

struct RsPre { float rs[2][4]; };
namespace pg8 {
constexpr int BM = 256, BK = 64, HALF = 128, HTB = HALF * BK * 2, STAGE_BYTES = 8 * HTB, NXCD = 8, WGM = 8;
__host__ __device__ __forceinline__ int lds_byte(int r, int c) { const int st = (r >> 4) * 2 + (c >> 5), rr = r & 15, cc = c & 31, ob = rr * 64 + cc * 2; return st * 1024 + (ob ^ (((ob >> 9) & 1) << 5)); }
__host__ __device__ __forceinline__ void stage_rc(int b, int& R, int& C) { const int st = b / 1024, sb = b % 1024, swz = sb ^ (((sb >> 9) & 1) << 5); R = (st >> 1) * 16 + swz / 64; C = (st & 1) * 32 + (swz % 64) / 2; }
__host__ __device__ __forceinline__ int perm32(int rho) { const int n = rho >> 4, i = rho & 15; return 8 * (i >> 2) + 4 * n + (i & 3); }
struct Unit { int pm, pn, k0, nt, split, alt; };
struct Gemm { const bf16_t* A; const bf16_t* Bt; int M, N, K, lda; const bf16_t* A2; const bf16_t* Bt2; };
struct StaticOrder {
    int nM, nN, nwg, G, c, ntK, nsplit, pairs;
    __device__ void init(int M, int N, int K, int G_, int c_, int nsplit_ = 0, int pairs_ = 0) { pairs = pairs_; nM = M / BM - (nsplit_ > 0 ? 1 : 0); nN = N / BM; nwg = nM * nN; G = G_; c = c_; ntK = K / BK; nsplit = nsplit_; }
    __device__ bool next(int i, Unit& u) const {
        const long L = (long)(pairs ? (i >> 1) : i) * G + c; u.alt = pairs ? (i & 1) : 0;
        if (L >= (long)nwg + nsplit * nN) return false;
        const bool tail = L >= nwg; const int j = tail ? (int)(L - nwg) : 0, ns = nsplit > 0 ? nsplit : 1;
        int wgid = tail ? 0 : (int)L; { const int q = nwg / NXCD, r = nwg % NXCD, xcd = wgid % NXCD, off = wgid / NXCD; wgid = (xcd < r ? xcd * (q + 1) : r * (q + 1) + (xcd - r) * q) + off; }
        const int nig = WGM * nN, gid = wgid / nig, fm = gid * WGM, gsz = (nM - fm) < WGM ? (nM - fm) : WGM;
        const int pmf = fm + ((wgid % nig) % gsz), pnf = (wgid % nig) / gsz, ntt = ntK / ns;
        u.pm = tail ? nM : pmf; u.pn = tail ? j % nN : pnf; u.nt = tail ? ntt : ntK; u.k0 = tail ? (j / nN) * ntt * BK : 0; u.split = tail ? (j / nN) + 1 : 0; return true;
    }
};

template <class Epi>
__device__ __forceinline__ void gemm_phase(LAS unsigned char* lds, const Gemm g, const StaticOrder& S, const Epi& E) {
    const int tid = otid();
    const int wid = __builtin_amdgcn_readfirstlane(tid >> 6), lane = tid & 63, wr = wid >> 2, wc = wid & 3, fr = lane & 15, fq = lane >> 4;
    const int K = g.K, lda = g.lda;
    unsigned voffA[2], voffB[2];
#pragma unroll
    for (int i = 0; i < 2; ++i) { int R, C; stage_rc(tid * 16 + i * 8192, R, C); const int Rb = Epi::PERM ? ((R & ~31) + perm32(R & 31)) : R;
        voffA[i] = (unsigned)(R * lda + C) * 2u; voffB[i] = (unsigned)(Rb * K + C) * 2u; }
    const size_t kstep = (size_t)(BK * 2);
    const size_t hA = (size_t)HALF * lda * 2, hB = (size_t)HALF * K * 2;
    const size_t tA = 2 * hA, tB = 2 * hB;
    const unsigned ldsw = (unsigned)wid * 1024u;
    const int aoff = lds_byte(wr * 64 + fr, fq * 8), boff = lds_byte(wc * 32 + fr, fq * 8);
#define PG8_SA(b, h) (((b) * 2 + (h)) * HTB)
#define PG8_SB(b, h) ((4 + (b) * 2 + (h)) * HTB)
#define PG8_STAGE(bufoff, gbase, voff) do { _Pragma("unroll") for (int _i = 0; _i < 2; ++_i) \
        __builtin_amdgcn_global_load_lds((const unsigned*)((const char*)(gbase) + (voff)[_i]), (LAS unsigned*)(lds + (bufoff) + ldsw + _i * 8192), 16, 0, 0); } while (0)
#define PG8_LDA(dst, b, h) do { _Pragma("unroll") for (int m = 0; m < 4; ++m) _Pragma("unroll") for (int k = 0; k < 2; ++k) dst[m][k] = *(const LAS bf16x8*)(lds + PG8_SA(b, h) + aoff + m * 2048 + k * 1024); } while (0)
#define PG8_LDB(dst, b, h) do { _Pragma("unroll") for (int n = 0; n < 2; ++n) _Pragma("unroll") for (int k = 0; k < 2; ++k) dst[n][k] = *(const LAS bf16x8*)(lds + PG8_SB(b, h) + boff + n * 2048 + k * 1024); } while (0)
#define PG8_MMA(ai, bj, At, Bt) do { __builtin_amdgcn_s_setprio(1); _Pragma("unroll") for (int m = 0; m < 4; ++m) _Pragma("unroll") for (int n = 0; n < 2; ++n) _Pragma("unroll") for (int k = 0; k < 2; ++k) \
        acc[ai][bj][m][n] = __builtin_amdgcn_mfma_f32_16x16x32_bf16(Bt[n][k], At[m][k], acc[ai][bj][m][n], 0, 0, 0); __builtin_amdgcn_s_setprio(0); } while (0)
#define PG8_WAIT_V(n) asm volatile("s_waitcnt vmcnt(" #n ")" ::: "memory")
#define PG8_WAIT_L(n) asm volatile("s_waitcnt lgkmcnt(" #n ")" ::: "memory")
#define PG8_BAR __builtin_amdgcn_s_barrier()
#define PG8_SCHED __builtin_amdgcn_sched_barrier(0)
    Unit cur, nxt; int ui = 0;
    if (!S.next(0, cur)) return;
    f32x4 acc[2][2][4][2];
#pragma unroll
    for (int a = 0; a < 2; ++a)
#pragma unroll
        for (int b = 0; b < 2; ++b)
#pragma unroll
            for (int m = 0; m < 4; ++m)
#pragma unroll
                for (int n = 0; n < 2; ++n) acc[a][b][m][n] = (f32x4){0.f, 0.f, 0.f, 0.f};
    bf16x8 At[4][2], B0[2][2], B1[2][2];
    RsPre pre;
    if constexpr (Epi::HAS_PRE) E.pre(pre, cur, wr, fr);
    const char* cA = (const char*)(cur.alt ? g.A2 : g.A) + (size_t)cur.pm * tA + (size_t)cur.k0 * 2; const char* cB = (const char*)(cur.alt ? g.Bt2 : g.Bt) + (size_t)cur.pn * tB + (size_t)cur.k0 * 2;
    PG8_STAGE(PG8_SB(0, 0), cB, voffB); PG8_STAGE(PG8_SA(0, 0), cA, voffA); PG8_STAGE(PG8_SB(0, 1), cB + hB, voffB); PG8_STAGE(PG8_SA(0, 1), cA + hA, voffA);
    if (wr == 1) PG8_BAR;
    PG8_WAIT_V(4); PG8_BAR;
    PG8_STAGE(PG8_SB(1, 0), cB + kstep, voffB); PG8_STAGE(PG8_SA(1, 0), cA + kstep, voffA); PG8_STAGE(PG8_SB(1, 1), cB + hB + kstep, voffB);
    PG8_WAIT_V(6); PG8_BAR;
    for (;;) {
        const bool has_next = S.next(ui + 1, nxt);
        const char* nA = has_next ? (const char*)(nxt.alt ? g.A2 : g.A) + (size_t)nxt.pm * tA + (size_t)nxt.k0 * 2 : cA; const char* nB = has_next ? (const char*)(nxt.alt ? g.Bt2 : g.Bt) + (size_t)nxt.pn * tB + (size_t)nxt.k0 * 2 : cB;
        const int nt = cur.nt;
        for (int t = 0; t < nt; t += 2) {
            const bool last = (t == nt - 2);
            const char* a1 = cA + (size_t)(t + 1) * kstep;
            const char* a2 = last ? nA : cA + (size_t)(t + 2) * kstep; const char* b2 = last ? nB : cB + (size_t)(t + 2) * kstep;
            const char* a3 = a2 + kstep; const char* b3 = b2 + kstep;
            PG8_LDB(B0, 0, 0); PG8_SCHED; PG8_LDA(At, 0, 0); PG8_STAGE(PG8_SA(1, 1), a1 + hA, voffA);
            PG8_WAIT_L(8); PG8_BAR; PG8_WAIT_L(0); PG8_MMA(0, 0, At, B0); PG8_BAR; PG8_SCHED;
            PG8_LDB(B1, 0, 1); PG8_STAGE(PG8_SB(0, 0), b2, voffB);
            PG8_BAR; PG8_WAIT_L(0); PG8_MMA(0, 1, At, B1); PG8_BAR;
            PG8_LDA(At, 0, 1); PG8_STAGE(PG8_SA(0, 0), a2, voffA);
            PG8_BAR; PG8_WAIT_L(0); PG8_MMA(1, 0, At, B0); PG8_BAR; PG8_SCHED;
            PG8_STAGE(PG8_SB(0, 1), b2 + hB, voffB);
            PG8_WAIT_V(6); PG8_BAR; PG8_MMA(1, 1, At, B1); PG8_BAR;
            PG8_LDB(B0, 1, 0); PG8_SCHED; PG8_LDA(At, 1, 0); PG8_STAGE(PG8_SA(0, 1), a2 + hA, voffA);
            PG8_WAIT_L(8); PG8_BAR; PG8_WAIT_L(0); PG8_MMA(0, 0, At, B0); PG8_BAR; PG8_SCHED;
            PG8_LDB(B1, 1, 1); PG8_STAGE(PG8_SB(1, 0), b3, voffB);
            PG8_BAR; PG8_WAIT_L(0); PG8_MMA(0, 1, At, B1); PG8_BAR;
            PG8_LDA(At, 1, 1); PG8_STAGE(PG8_SA(1, 0), a3, voffA);
            PG8_BAR; PG8_WAIT_L(0); PG8_MMA(1, 0, At, B0); PG8_BAR; PG8_SCHED;
            PG8_STAGE(PG8_SB(1, 1), b3 + hB, voffB);
            PG8_WAIT_V(6); PG8_BAR; PG8_MMA(1, 1, At, B1); PG8_BAR;
        }
        if constexpr (Epi::HAS_PRE) { E(acc, cur, wr, wc, fr, fq, pre); if (has_next) E.pre(pre, nxt, wr, fr); } else E(acc, cur, wr, wc, fr, fq);
        if (!has_next) break;
        if (!(Epi::PAIRS && cur.alt == 0)) {
#pragma unroll
        for (int a = 0; a < 2; ++a)
#pragma unroll
            for (int b = 0; b < 2; ++b)
#pragma unroll
                for (int m = 0; m < 4; ++m)
#pragma unroll
                    for (int n = 0; n < 2; ++n) acc[a][b][m][n] = (f32x4){0.f, 0.f, 0.f, 0.f}; }
        cur = nxt; cA = nA; cB = nB; ++ui;
    }
    PG8_WAIT_V(0);
    if (wr == 0) PG8_BAR;
    PG8_BAR;
#undef PG8_SA
#undef PG8_SB
#undef PG8_STAGE
#undef PG8_LDA
#undef PG8_LDB
#undef PG8_MMA
#undef PG8_WAIT_V
#undef PG8_WAIT_L
#undef PG8_BAR
#undef PG8_SCHED
}
}
using pg8::Unit;
typedef f32x4 Acc[2][2][4][2];

__device__ __forceinline__ u32x4 pack8(const f32x4 a, const f32x4 b) { u32x4 w; w.x = cvt_pk_bf16(a[0], a[1]); w.y = cvt_pk_bf16(a[2], a[3]); w.z = cvt_pk_bf16(b[0], b[1]); w.w = cvt_pk_bf16(b[2], b[3]); return w; }
__device__ __forceinline__ void unpack8(const u32x4 w, f32x4& a, f32x4& b) { a = (f32x4){bflo(w.x), bfhi(w.x), bflo(w.y), bfhi(w.y)}; b = (f32x4){bflo(w.z), bfhi(w.z), bflo(w.w), bfhi(w.w)}; }
__device__ __forceinline__ f32x4 sig4(const f32x4 v) { return (f32x4){sigmoidf_(v[0]), sigmoidf_(v[1]), sigmoidf_(v[2]), sigmoidf_(v[3])}; }

__device__ __forceinline__ float row_rs(const float* ssq, int row) {
    const f32x4* q = (const f32x4*)(ssq + (size_t)row * 16); const f32x4 a = q[0], b = q[1], c = q[2], d = q[3];
    const float s = ((a[0] + a[1]) + (a[2] + a[3])) + ((b[0] + b[1]) + (b[2] + b[3])) + ((c[0] + c[1]) + (c[2] + c[3])) + ((d[0] + d[1]) + (d[2] + d[3]));
    return rsqrtf(s * (1.0f / DM) + EPS);
}
struct EpiStore {
    static constexpr bool PERM = true, HAS_PRE = true, PAIRS = false;
    bf16_t* O; int ldc; const float* rsv;
    __device__ __forceinline__ void pre(RsPre& r, const Unit& u, int wr, int fr) const {
#pragma unroll
        for (int ai = 0; ai < 2; ++ai)
#pragma unroll
            for (int m = 0; m < 4; ++m) r.rs[ai][m] = rsv[u.pm * 256 + wr * 64 + fr + ai * 128 + m * 16]; }
    __device__ __forceinline__ void operator()(const Acc& acc, const Unit& u, int wr, int wc, int fr, int fq, const RsPre& pr) const {
        asm volatile("" : "+v"(fr), "+v"(fq));
        const int row0 = u.pm * 256 + wr * 64 + fr, col0 = u.pn * 256 + wc * 32 + 8 * fq;
        const float (&rs)[2][4] = pr.rs;
#pragma unroll
        for (int ai = 0; ai < 2; ++ai)
#pragma unroll
            for (int m = 0; m < 4; ++m) { bf16_t* rowp = O + (size_t)(row0 + ai * 128 + m * 16) * ldc + col0;
#pragma unroll
                for (int bj = 0; bj < 2; ++bj) *(u32x4*)(rowp + bj * 128) = pack8(acc[ai][bj][m][0] * rs[ai][m], acc[ai][bj][m][1] * rs[ai][m]); }
    }
};
struct EpiGlu {
    static constexpr bool PERM = true, HAS_PRE = false, PAIRS = false;
    bf16_t* proj; const float* bias;
    __device__ __forceinline__ void operator()(const Acc& acc, const Unit& u, int wr, int wc, int fr, int fq) const {
        asm volatile("" : "+v"(fr), "+v"(fq));
        const int row0 = u.pm * 256 + wr * 64 + fr, col0 = u.pn * 256 + wc * 32 + 8 * fq;
        f32x4 bv[2][2];
#pragma unroll
        for (int bj = 0; bj < 2; ++bj)
#pragma unroll
            for (int n = 0; n < 2; ++n) bv[bj][n] = *(const f32x4*)(bias + col0 + bj * 128 + 4 * n);
#pragma unroll
        for (int ai = 0; ai < 2; ++ai) {
            u32x4 av[4][2];
#pragma unroll
            for (int m = 0; m < 4; ++m)
#pragma unroll
                for (int bj = 0; bj < 2; ++bj) av[m][bj] = *(const u32x4*)(proj + (size_t)(row0 + ai * 128 + m * 16) * NPROJ + col0 + bj * 128);
#pragma unroll
            for (int m = 0; m < 4; ++m) { bf16_t* rowp = proj + (size_t)(row0 + ai * 128 + m * 16) * NPROJ + col0;
#pragma unroll
                for (int bj = 0; bj < 2; ++bj) { f32x4 a0, a1; unpack8(av[m][bj], a0, a1);
                    const f32x4 o0 = a0 * sig4(acc[ai][bj][m][0] + bv[bj][0]), o1 = a1 * sig4(acc[ai][bj][m][1] + bv[bj][1]);
                    *(u32x4*)(rowp + C_GLU + bj * 128) = pack8(o0, o1); } } }
    }
};
template <int SECOND> struct EpiMix {
    static constexpr bool PERM = true, HAS_PRE = false, PAIRS = false;
    const bf16_t* gate; bf16_t* mixed;
    __device__ __forceinline__ void operator()(const Acc& acc, const Unit& u, int wr, int wc, int fr, int fq) const {
        asm volatile("" : "+v"(fr), "+v"(fq));
        const int row0 = u.pm * 256 + wr * 64 + fr, col0 = u.pn * 256 + wc * 32 + 8 * fq;
#pragma unroll
        for (int ai = 0; ai < 2; ++ai) {
            u32x4 gv[4][2], pv[4][2];
#pragma unroll
            for (int m = 0; m < 4; ++m)
#pragma unroll
                for (int bj = 0; bj < 2; ++bj) { const size_t row = (size_t)(row0 + ai * 128 + m * 16);
                    gv[m][bj] = *(const u32x4*)(gate + row * NPROJ + col0 + bj * 128);
                    if (SECOND) pv[m][bj] = *(const u32x4*)(mixed + row * 1024 + col0 + bj * 128); }
#pragma unroll
            for (int m = 0; m < 4; ++m) { const size_t row = (size_t)(row0 + ai * 128 + m * 16);
#pragma unroll
                for (int bj = 0; bj < 2; ++bj) { f32x4 g0, g1; unpack8(gv[m][bj], g0, g1);
                    f32x4 o0 = acc[ai][bj][m][0] * sig4(g0), o1 = acc[ai][bj][m][1] * sig4(g1);
                    if (SECOND) { f32x4 p0, p1; unpack8(pv[m][bj], p0, p1); o0 += p0; o1 += p1; }
                    *(u32x4*)(mixed + row * 1024 + col0 + bj * 128) = pack8(o0, o1); } } }
    }
};
struct EpiMixPair {
    static constexpr bool PERM = true, HAS_PRE = false, PAIRS = true;
    const bf16_t* ga; const bf16_t* gb; bf16_t* mixed;
    __device__ __forceinline__ void operator()(Acc& acc, const Unit& u, int wr, int wc, int fr, int fq) const {
        asm volatile("" : "+v"(fr), "+v"(fq));
        const int row0 = u.pm * 256 + wr * 64 + fr, col0 = u.pn * 256 + wc * 32 + 8 * fq;
#pragma unroll
        for (int ai = 0; ai < 2; ++ai) {
            u32x4 av[4][2], bv[4][2];
#pragma unroll
            for (int m = 0; m < 4; ++m)
#pragma unroll
                for (int bj = 0; bj < 2; ++bj) { const size_t off = (size_t)(row0 + ai * 128 + m * 16) * NPROJ + col0 + bj * 128;
                    bv[m][bj] = *(const u32x4*)(gb + off); if (u.alt == 0) av[m][bj] = *(const u32x4*)(ga + off); }
#pragma unroll
            for (int m = 0; m < 4; ++m)
#pragma unroll
                for (int bj = 0; bj < 2; ++bj) { f32x4 b0, b1; unpack8(bv[m][bj], b0, b1);
                    if (u.alt == 0) { f32x4 a0, a1; unpack8(av[m][bj], a0, a1);
#pragma unroll
                        for (int r = 0; r < 4; ++r) { acc[ai][bj][m][0][r] *= (1.0f + __expf(-b0[r])) * __builtin_amdgcn_rcpf(1.0f + __expf(-a0[r]));
                                                      acc[ai][bj][m][1][r] *= (1.0f + __expf(-b1[r])) * __builtin_amdgcn_rcpf(1.0f + __expf(-a1[r])); } }
                    else *(u32x4*)(mixed + (size_t)(row0 + ai * 128 + m * 16) * 1024 + col0 + bj * 128) = pack8(acc[ai][bj][m][0] * sig4(b0), acc[ai][bj][m][1] * sig4(b1)); } }
    }
};
struct EpiRes {
    static constexpr bool PERM = true, HAS_PRE = false, PAIRS = false;
    bf16_t* hb; float sc; float* part; float* ssq;
    __device__ __forceinline__ void operator()(const Acc& acc, const Unit& u, int wr, int wc, int fr, int fq) const {
        asm volatile("" : "+v"(fr), "+v"(fq));
        const int row0 = u.pm * 256 + wr * 64 + fr, col0 = u.pn * 256 + wc * 32 + 8 * fq;
        if (u.split) {
            float* pt = part + (size_t)(u.split - 1) * 256 * DM;
#pragma unroll
            for (int ai = 0; ai < 2; ++ai)
#pragma unroll
                for (int m = 0; m < 4; ++m)
#pragma unroll
                    for (int bj = 0; bj < 2; ++bj)
#pragma unroll
                        for (int n = 0; n < 2; ++n) *(f32x4*)(pt + (size_t)(wr * 64 + fr + ai * 128 + m * 16) * DM + col0 + bj * 128 + n * 4) = acc[ai][bj][m][n] * sc;
            return; }
#pragma unroll
        for (int ai = 0; ai < 2; ++ai) {
            u32x4 hv[4][2];
#pragma unroll
            for (int m = 0; m < 4; ++m)
#pragma unroll
                for (int bj = 0; bj < 2; ++bj) hv[m][bj] = *(const u32x4*)(hb + (size_t)(row0 + ai * 128 + m * 16) * DM + col0 + bj * 128);
#pragma unroll
            for (int m = 0; m < 4; ++m) { const size_t row = (size_t)(row0 + ai * 128 + m * 16); float sq = 0.f;
#pragma unroll
                for (int bj = 0; bj < 2; ++bj) { f32x4 o0, o1; unpack8(hv[m][bj], o0, o1); o0 += acc[ai][bj][m][0] * sc; o1 += acc[ai][bj][m][1] * sc;
                    *(u32x4*)(hb + row * DM + col0 + bj * 128) = pack8(o0, o1);
                    sq += ((o0[0] * o0[0] + o0[1] * o0[1]) + (o0[2] * o0[2] + o0[3] * o0[3])) + ((o1[0] * o1[0] + o1[1] * o1[1]) + (o1[2] * o1[2] + o1[3] * o1[3])); }
                const int lane = fq * 16 + fr; sq += shx(sq, lane, 16); sq += shx(sq, lane, 32);
                if (fq == 0) ssq[row * 16 + u.pn * 4 + wc] = sq; } }
    }
};
struct EpiFF {
    static constexpr bool PERM = true, HAS_PRE = true, PAIRS = false;
    bf16_t* ff; const float* rsv;
    __device__ __forceinline__ void pre(RsPre& r, const Unit& u, int wr, int fr) const {
#pragma unroll
        for (int ai = 0; ai < 2; ++ai)
#pragma unroll
            for (int m = 0; m < 4; ++m) r.rs[ai][m] = rsv[u.pm * 256 + wr * 64 + fr + ai * 128 + m * 16]; }
    __device__ __forceinline__ void operator()(const Acc& acc, const Unit& u, int wr, int wc, int fr, int fq, const RsPre& pr) const {
        asm volatile("" : "+v"(fr), "+v"(fq));
        const int row0 = u.pm * 256 + wr * 64 + fr, col0 = u.pn * 128 + wc * 32 + 8 * fq;
        const float (&rs)[2][4] = pr.rs;
#pragma unroll
        for (int ai = 0; ai < 2; ++ai)
#pragma unroll
            for (int m = 0; m < 4; ++m) { f32x4 o[2];
#pragma unroll
                for (int n = 0; n < 2; ++n) { const f32x4 a1 = acc[ai][0][m][n] * rs[ai][m], a3 = acc[ai][1][m][n] * rs[ai][m];
                    o[n] = (f32x4){siluf_(a1[0]) * a3[0], siluf_(a1[1]) * a3[1], siluf_(a1[2]) * a3[2], siluf_(a1[3]) * a3[3]}; }
                *(u32x4*)(ff + (size_t)(row0 + ai * 128 + m * 16) * DFF + col0) = pack8(o[0], o[1]); }
    }
};

__device__ __forceinline__ void conv_tile(const float* src, int ldsrc, int scol0, int k0, bf16_t* dst, int drow0, int K, float* lds, const float* ks = nullptr) {
    const int t = otid();
#pragma unroll
    for (int i = 0; i < 2; ++i) { const int r = (t >> 4) + 32 * i, c4 = (t & 15) * 4;
        const f32x4 v = *(const f32x4*)(src + (size_t)(k0 + r) * ldsrc + scol0 + c4);
        lds[r * 65 + c4 + 0] = v[0]; lds[r * 65 + c4 + 1] = v[1]; lds[r * 65 + c4 + 2] = v[2]; lds[r * 65 + c4 + 3] = v[3]; }
    __syncthreads();
    { const int n = t >> 3, kc = (t & 7) * 8; float v[8];
#pragma unroll
      for (int j = 0; j < 8; ++j) v[j] = lds[(kc + j) * 65 + n];
      if (ks) {
#pragma unroll
          for (int j = 0; j < 8; ++j) v[j] *= ks[k0 + kc + j]; }
      u32x4 w; w.x = cvt_pk_bf16(v[0], v[1]); w.y = cvt_pk_bf16(v[2], v[3]); w.z = cvt_pk_bf16(v[4], v[5]); w.w = cvt_pk_bf16(v[6], v[7]);
      *(u32x4*)(dst + (size_t)(drow0 + n) * K + k0 + kc) = w; }
    __syncthreads();
}
struct Sub4 { int scol[4], drow[4]; };
__device__ __forceinline__ void conv_tile4(const float* src, int ldsrc, const Sub4& sb, int k0, bf16_t* dst, int K, float* lds, const float* ks) {
    const int t = otid(); f32x4 v[4][2];
#pragma unroll
    for (int j = 0; j < 4; ++j)
#pragma unroll
        for (int i = 0; i < 2; ++i) v[j][i] = *(const f32x4*)(src + (size_t)(k0 + (t >> 4) + 32 * i) * ldsrc + sb.scol[j] + (t & 15) * 4);
    __syncthreads();
#pragma unroll
    for (int j = 0; j < 4; ++j)
#pragma unroll
        for (int i = 0; i < 2; ++i) { float* q = lds + j * 4160 + ((t >> 4) + 32 * i) * 65 + (t & 15) * 4; q[0] = v[j][i][0]; q[1] = v[j][i][1]; q[2] = v[j][i][2]; q[3] = v[j][i][3]; }
    __syncthreads();
    const int n = t >> 3, kc = (t & 7) * 8; float sc[8];
#pragma unroll
    for (int e = 0; e < 8; ++e) sc[e] = ks ? ks[k0 + kc + e] : 1.0f;
#pragma unroll
    for (int j = 0; j < 4; ++j) { float x[8];
#pragma unroll
        for (int e = 0; e < 8; ++e) x[e] = lds[j * 4160 + (kc + e) * 65 + n] * sc[e];
        u32x4 w; w.x = cvt_pk_bf16(x[0], x[1]); w.y = cvt_pk_bf16(x[2], x[3]); w.z = cvt_pk_bf16(x[4], x[5]); w.w = cvt_pk_bf16(x[6], x[7]);
        *(u32x4*)(dst + (size_t)(sb.drow[j] + n) * K + k0 + kc) = w; }
}
constexpr int NCONV_MIX = 256 + 64 + 16 + 32 + 32 + 64;
__device__ void conv_mixer_item(const Params& p, int l, int it, float* lds) {
    bf16_t* W = (bf16_t*)(p.ws + WS_W); Sub4 sb;
    if (it < 256) { const int kt = it & 15, nb = it >> 4;
#pragma unroll
        for (int j = 0; j < 4; ++j) { const int mycol = (nb < 8 ? nb * 256 : 2304 + (nb - 8) * 256) + j * 64; sb.drow[j] = mycol; sb.scol[j] = nb < 8 ? mycol : mycol - 240; }
        conv_tile4(p.w_in + (size_t)l * 1024 * 4112, 4112, sb, kt * 64, W + W_IN, 1024, lds, p.norm1 + (size_t)l * DM); return; }
    it -= 256;
    if (it < 64) {
        const int kb = it & 1, jb = it >> 1, k = kb * 512 + otid();
        const float* src = p.w_in + (size_t)l * 1024 * 4112 + (size_t)k * 4112 + 2048; float a[16];
#pragma unroll
        for (int q = 0; q < 4; ++q) { const f32x4 v = *(const f32x4*)(src + 4 * q); a[4 * q] = v[0]; a[4 * q + 1] = v[1]; a[4 * q + 2] = v[2]; a[4 * q + 3] = v[3]; }
        const float* wa = p.w_alpha + (size_t)l * 16 * 256; const float g1 = p.norm1[(size_t)l * DM + k];
        for (int jj = 0; jj < 8; ++jj) { const int j = jb * 8 + jj; float s = 0.f;
#pragma unroll
            for (int r = 0; r < 16; ++r) s += a[r] * wa[r * 256 + j];
            W[W_IN + (size_t)(C_GL + j) * 1024 + k] = f2bf(s * g1); }
        return; }
    it -= 64;
    const float* src; int ld, kt, nb, K; size_t wo;
    if (it < 16) { src = p.w_glu + (size_t)l * 512 * 512; ld = 512; kt = it & 7; nb = it >> 3; K = 512; wo = W_GLU; }
    else if ((it -= 16) < 32) { src = p.w_pa + (size_t)l * 512 * 1024; ld = 1024; kt = it & 7; nb = it >> 3; K = 512; wo = W_PA; }
    else if ((it -= 32) < 32) { src = p.w_pb + (size_t)l * 512 * 1024; ld = 1024; kt = it & 7; nb = it >> 3; K = 512; wo = W_PB; }
    else { it -= 32; src = p.w_out + (size_t)l * 1024 * 1024; ld = 1024; kt = it & 15; nb = it >> 4; K = 1024; wo = W_OUT; }
#pragma unroll
    for (int j = 0; j < 4; ++j) { sb.scol[j] = nb * 256 + j * 64; sb.drow[j] = nb * 256 + j * 64; }
    conv_tile4(src, ld, sb, kt * 64, W + wo, K, lds, nullptr);
}
constexpr int NCONV_FF = 3 * 176;
__device__ void conv_ff_item(const Params& p, int l, int it, float* lds) {
    bf16_t* W = (bf16_t*)(p.ws + WS_W); Sub4 sb;
    if (it < 352) { const int which = it >= 176; if (which) it -= 176;
        const int kt = it & 15, nb = it >> 4;
        const float* src = (which ? p.w_ff3 : p.w_ff1) + (size_t)l * 1024 * DFF;
#pragma unroll
        for (int j = 0; j < 4; ++j) { const int n0 = nb * 256 + j * 64; sb.scol[j] = n0; sb.drow[j] = (n0 >> 7) * 256 + (n0 & 127) + which * 128; }
        conv_tile4(src, DFF, sb, kt * 64, W + W_FF13, 1024, lds, p.norm2 + (size_t)l * DM); return; }
    it -= 352;
    { const int nb = it & 3, kt = it >> 2;
#pragma unroll
      for (int j = 0; j < 4; ++j) { sb.scol[j] = nb * 256 + j * 64; sb.drow[j] = nb * 256 + j * 64; }
      conv_tile4(p.w_ff2 + (size_t)l * DFF * 1024, 1024, sb, kt * 64, W + W_FF2, DFF, lds, nullptr); }
}

__device__ __forceinline__ void sincos_small(float x, float& sn, float& cs) {
    const float k = rintf(x * 0.636619772f);
    float r = fmaf(-k, 1.5703125f, x); r = fmaf(-k, 4.837512969970703125e-4f, r); r = fmaf(-k, 7.54978995489188216e-8f, r);
    const int q = ((int)k) & 3; const float r2 = r * r;
    const float sp = r + r * r2 * (-1.6666654611e-1f + r2 * (8.3321608736e-3f + r2 * (-1.9515295891e-4f)));
    const float cp = 1.0f - 0.5f * r2 + r2 * r2 * (4.166664568298827e-2f + r2 * (-1.388731625493765e-3f + r2 * 2.443315711809948e-5f));
    sn = (q == 0) ? sp : (q == 1) ? cp : (q == 2) ? -sp : -cp;
    cs = (q == 0) ? cp : (q == 1) ? -sp : (q == 2) ? -cp : sp;
}
__device__ void s5_prep_item(const Params& p, int l, int gi, float* lds) {
    const int g = gi >> 3, part = gi & 7;
    __syncthreads();
    float* ap_re = lds;
    float* ap_im = ap_re + 17 * 64;
    float* bb_re = ap_im + 17 * 64;
    float* bb_im = bb_re + 1024;
    float* cc_re = bb_im + 1024;
    float* cc_im = cc_re + 1024;
    float* Kd = cc_im + 1024;
    const int t = otid();
    const size_t lg = (size_t)l * 32 + g;
    if (t < 64) { const int pp = t;
        const float step = expf(p.log_step[lg]);
        const float lr = fminf(p.lam_re[lg * 64 + pp], -1e-4f), li = p.lam_im[lg * 64 + pp];
        const float mag = expf(lr * step); float sn, cs; sincos_small(li * step, sn, cs);
        const float abr = mag * cs, abi = mag * sn;
        float pr = 1.f, pi = 0.f;
        for (int d = 0; d <= 16; ++d) { ap_re[d * 64 + pp] = pr; ap_im[d * 64 + pp] = pi; const float nr_ = pr * abr - pi * abi, ni_ = pr * abi + pi * abr; pr = nr_; pi = ni_; }
        const float den = lr * lr + li * li, nr = abr - 1.0f, cr = (nr * lr + abi * li) / den, ci = (abi * lr - nr * li) / den;
        for (int h = 0; h < 16; ++h) { const float br = p.b_re[(lg * 64 + pp) * 16 + h], bi = p.b_im[(lg * 64 + pp) * 16 + h];
            bb_re[pp * 16 + h] = cr * br - ci * bi; bb_im[pp * 16 + h] = cr * bi + ci * br; }
        if (part == 0) { float* a16 = (float*)(p.ws + WS_A16) + (g * 64 + pp) * 2; a16[0] = ap_re[16 * 64 + pp]; a16[1] = ap_im[16 * 64 + pp]; }
    }
    for (int i = t; i < 1024; i += 512) { cc_re[i] = p.c_re[lg * 1024 + i]; cc_im[i] = p.c_im[lg * 1024 + i]; }
    __syncthreads();
    for (int i3 = t; i3 < 768; i3 += 512) { const int d = 2 * part - 1 + (i3 >> 8); if (d < 0) continue;
        const int idx = (d << 8) + (i3 & 255), h = (idx >> 4) & 15, h2 = idx & 15; float s = 0.f;
        for (int pp = 0; pp < 64; ++pp) { const float cr = cc_re[h * 64 + pp], ci = cc_im[h * 64 + pp], ar = ap_re[d * 64 + pp], ai = ap_im[d * 64 + pp];
            const float gr = cr * ar - ci * ai, gi = cr * ai + ci * ar; s += gr * bb_re[pp * 16 + h2] - gi * bb_im[pp * 16 + h2]; }
        Kd[idx] = s; }
    __syncthreads();
    bf16_t* Wy = (bf16_t*)(p.ws + WS_WY) + (size_t)g * 256 * 384;
    for (int i2 = part * 4096 + t; i2 < (part + 1) * 4096; i2 += 512) { const int n = i2 >> 7, kk = i2 & 127, j = n >> 4, h = n & 15, pp = kk & 63, im = kk >> 6;
        const float cr = cc_re[h * 64 + pp], ci = cc_im[h * 64 + pp], ar = ap_re[(j + 1) * 64 + pp], ai = ap_im[(j + 1) * 64 + pp];
        Wy[(size_t)n * 384 + 256 + kk] = f2bf(im ? -(cr * ai + ci * ar) : (cr * ar - ci * ai)); }
    bf16_t* Tz = (bf16_t*)(p.ws + WS_TZ) + (size_t)g * 16 * 512;
    for (int idx = part * 1024 + t; idx < (part + 1) * 1024; idx += 512) { const int d = idx >> 9, h = (idx >> 5) & 15, kk = idx & 31, sl = kk >> 4, h2 = kk & 15, lag = d - sl;
        Tz[idx] = f2bf(lag >= 0 ? Kd[(lag << 8) + (h << 4) + h2] : 0.f); }
    bf16_t* We = (bf16_t*)(p.ws + WS_WE) + (size_t)g * 128 * 256;
    for (int idx = part * 4096 + t; idx < (part + 1) * 4096; idx += 512) { const int n = idx >> 8, k = idx & 255, pp = n & 63, im = n >> 6, s = k >> 4, h2 = k & 15;
        const float ar = ap_re[(15 - s) * 64 + pp], ai = ap_im[(15 - s) * 64 + pp], br = bb_re[pp * 16 + h2], bi = bb_im[pp * 16 + h2];
        We[idx] = f2bf(im ? (ar * bi + ai * br) : (ar * br - ai * bi)); }
    __syncthreads();
}

__device__ __forceinline__ float wave_sum(float v, int lane) {
#pragma unroll
    for (int o = 32; o >= 1; o >>= 1) v += shx(v, lane, o);
    return v;
}
__device__ void rmsnorm_rows(const Params& p, float* h, const float* gain, bf16_t* z, int nslice) {
    const int t_ = otid(), wave = t_ >> 6, lane = t_ & 63;
    f32x4 gv[4];
#pragma unroll
    for (int i = 0; i < 4; ++i) gv[i] = *(const f32x4*)(gain + lane * 4 + 256 * i);
    for (int row0 = p.bid * 16 + wave * 2; row0 < MP; row0 += p.nblk * 16) {
        f32x4 v[2][4];
#pragma unroll
        for (int rr = 0; rr < 2; ++rr)
#pragma unroll
            for (int i = 0; i < 4; ++i) v[rr][i] = *(const f32x4*)(h + (size_t)(row0 + rr) * DM + lane * 4 + 256 * i);
#pragma unroll
        for (int rr = 0; rr < 2; ++rr) { const int row = row0 + rr; float* hp = h + (size_t)row * DM; float ss = 0.f;
            if (row >= MP - 256 && nslice > 0) {
                const float* pt = (const float*)(p.ws + WS_PART) + (size_t)(row - (MP - 256)) * DM + lane * 4;
                for (int sl = 0; sl < nslice; ++sl)
#pragma unroll
                    for (int i = 0; i < 4; ++i) v[rr][i] += *(const f32x4*)(pt + (size_t)sl * 256 * DM + 256 * i);
#pragma unroll
                for (int i = 0; i < 4; ++i) *(f32x4*)(hp + lane * 4 + 256 * i) = v[rr][i]; }
#pragma unroll
            for (int i = 0; i < 4; ++i) ss += v[rr][i][0] * v[rr][i][0] + v[rr][i][1] * v[rr][i][1] + v[rr][i][2] * v[rr][i][2] + v[rr][i][3] * v[rr][i][3];
            ss = wave_sum(ss, lane); const float rs = rsqrtf(ss * (1.0f / DM) + EPS);
#pragma unroll
            for (int i = 0; i < 4; ++i) { const f32x4 o = v[rr][i] * rs * gv[i]; u32x2 w; w.x = cvt_pk_bf16(o[0], o[1]); w.y = cvt_pk_bf16(o[2], o[3]);
                *(u32x2*)(z + (size_t)row * DM + lane * 4 + 256 * i) = w; } }
    }
}
__device__ void final_norm(const Params& p, const bf16_t* hb, const float* gain, float* out) {
    const int t_ = otid(), wave = t_ >> 6, lane = t_ & 63;
    f32x4 gv[4];
#pragma unroll
    for (int i = 0; i < 4; ++i) gv[i] = *(const f32x4*)(gain + lane * 4 + 256 * i);
    for (int orow = p.bid * 8 + wave; orow < NBATCH * SEQ; orow += p.nblk * 8) {
        const int b = orow >> 12, tt = orow & 4095, row = b * TB + NMETA + tt; const bf16_t* hp = hb + (size_t)row * DM; f32x4 v[4]; float ss = 0.f;
#pragma unroll
        for (int i = 0; i < 4; ++i) { const u32x2 w = *(const u32x2*)(hp + lane * 4 + 256 * i); v[i] = (f32x4){bflo(w.x), bfhi(w.x), bflo(w.y), bfhi(w.y)}; }
        if (row >= MP - 256) { const float* pt = (const float*)(p.ws + WS_PART) + (size_t)(row - (MP - 256)) * DM + lane * 4;
            for (int sl = 0; sl < 11; ++sl)
#pragma unroll
                for (int i = 0; i < 4; ++i) v[i] += *(const f32x4*)(pt + (size_t)sl * 256 * DM + 256 * i); }
#pragma unroll
        for (int i = 0; i < 4; ++i) ss += v[i][0] * v[i][0] + v[i][1] * v[i][1] + v[i][2] * v[i][2] + v[i][3] * v[i][3];
        ss = wave_sum(ss, lane); const float rs = rsqrtf(ss * (1.0f / DM) + EPS);
#pragma unroll
        for (int i = 0; i < 4; ++i) *(f32x4*)(out + (size_t)orow * DM + lane * 4 + 256 * i) = v[i] * rs * gv[i];
    }
}
__device__ void init_h(const Params& p) {
    bf16_t* hb = (bf16_t*)(p.ws + WS_H);
    const int t_ = otid(), wave = t_ >> 6, lane = t_ & 63;
    for (int row0 = (p.bid * 8 + wave) * 2; row0 < MP; row0 += p.nblk * 16) {
        f32x4 v[2][4];
#pragma unroll
        for (int rr = 0; rr < 2; ++rr) { const int row = row0 + rr, b = row / TB, r = row - b * TB;
#pragma unroll
            for (int i = 0; i < 4; ++i) { const int c4 = lane * 4 + 256 * i; v[rr][i] = (f32x4){0.f, 0.f, 0.f, 0.f};
                if (r < NMETA) v[rr][i] = *(const f32x4*)(p.meta + (size_t)r * DM + c4);
                else if (r < NMETA + SEQ) v[rr][i] = *(const f32x4*)(p.x + ((size_t)b * SEQ + (r - NMETA)) * DM + c4); } }
#pragma unroll
        for (int rr = 0; rr < 2; ++rr) { const int row = row0 + rr; float ss = 0.f;
#pragma unroll
            for (int i = 0; i < 4; ++i) { const int c4 = lane * 4 + 256 * i;
                u32x2 w; w.x = cvt_pk_bf16(v[rr][i][0], v[rr][i][1]); w.y = cvt_pk_bf16(v[rr][i][2], v[rr][i][3]); *(u32x2*)(hb + (size_t)row * DM + c4) = w;
                ss += v[rr][i][0] * v[rr][i][0] + v[rr][i][1] * v[rr][i][1] + v[rr][i][2] * v[rr][i][2] + v[rr][i][3] * v[rr][i][3]; }
            ss = wave_sum(ss, lane);
            if (lane == 0) ((float*)(p.ws + WS_RS1))[row] = rsqrtf(ss * (1.0f / DM) + EPS); }
    }
}
__device__ void fold_rows(const Params& p, int nslice, const float* ssq, float* rsv) {
    bf16_t* hb = (bf16_t*)(p.ws + WS_H);
    const int t_ = otid(), wave = t_ >> 6, lane = t_ & 63;
    for (int idx = p.bid * 8 + wave; idx < 256; idx += p.nblk * 8) {
        const int row = MP - 256 + idx; bf16_t* hp = hb + (size_t)row * DM; f32x4 v[4]; float ss = 0.f;
#pragma unroll
        for (int i = 0; i < 4; ++i) { const u32x2 w = *(const u32x2*)(hp + lane * 4 + 256 * i); v[i] = (f32x4){bflo(w.x), bfhi(w.x), bflo(w.y), bfhi(w.y)}; }
        const float* pt = (const float*)(p.ws + WS_PART) + (size_t)idx * DM + lane * 4;
        for (int s0 = 0; s0 < nslice; s0 += 4) {
            f32x4 tq[4][4];
#pragma unroll
            for (int q = 0; q < 4; ++q) { const int sl = s0 + q < nslice ? s0 + q : nslice - 1;
#pragma unroll
                for (int i = 0; i < 4; ++i) tq[q][i] = *(const f32x4*)(pt + (size_t)sl * 256 * DM + 256 * i); }
#pragma unroll
            for (int q = 0; q < 4; ++q) { const float on = s0 + q < nslice ? 1.f : 0.f;
#pragma unroll
                for (int i = 0; i < 4; ++i) v[i] += tq[q][i] * on; } }
#pragma unroll
        for (int i = 0; i < 4; ++i) { u32x2 w; w.x = cvt_pk_bf16(v[i][0], v[i][1]); w.y = cvt_pk_bf16(v[i][2], v[i][3]); *(u32x2*)(hp + lane * 4 + 256 * i) = w;
            ss += v[i][0] * v[i][0] + v[i][1] * v[i][1] + v[i][2] * v[i][2] + v[i][3] * v[i][3]; }
        ss = wave_sum(ss, lane);
        if (lane == 0) rsv[row] = rsqrtf(ss * (1.0f / DM) + EPS);
    }
    for (int row = p.bid * 512 + t_; row < MP - 256; row += p.nblk * 512) rsv[row] = row_rs(ssq, row);
}

constexpr int S5_ITEMS = 512;
__device__ void s5a_item(const Params& p, int item, LAS unsigned char* lds) {
    const int xcd_ = item & 7, slot_ = (item >> 3) & 31, g = xcd_ * 4 + (slot_ & 3), span = (item >> 8) * 8 + (slot_ >> 2), mt0 = span * 8, nmt = span == 15 ? 9 : 8;
    const int t = otid(), wave = t >> 6, lane = t & 63, fr = lane & 15, fq = lane >> 4;
    const bf16_t* proj = (const bf16_t*)(p.ws + WS_PROJ);
    const bf16_t* We = (const bf16_t*)(p.ws + WS_WE) + (size_t)g * 128 * 256;
    float* Xloc = (float*)(p.ws + WS_XLOC);
    u32x4 wf[8];
#pragma unroll
    for (int q = 0; q < 8; ++q) { const int i = t + 512 * q, r = i >> 5, c = i & 31; wf[q] = *(const u32x4*)(We + r * 256 + c * 8); }
    bf16x8 a[8];
    { const int mt = mt0 + wave;
#pragma unroll
      for (int ks = 0; ks < 8; ++ks) a[ks] = *(const bf16x8*)(proj + (size_t)((mt * 16 + fr) * 16 + 2 * ks + (fq >> 1)) * NPROJ + C_U + g * 16 + (fq & 1) * 8); }
    __syncthreads();
#pragma unroll
    for (int q = 0; q < 8; ++q) { const int i = t + 512 * q, r = i >> 5, c = i & 31; *(LAS u32x4*)(lds + r * 528 + c * 16) = wf[q]; }
    __syncthreads();
    for (int mt = mt0 + wave; mt < mt0 + nmt; mt += 8) {
        if (mt != mt0 + wave) {
#pragma unroll
            for (int ks = 0; ks < 8; ++ks) a[ks] = *(const bf16x8*)(proj + (size_t)((mt * 16 + fr) * 16 + 2 * ks + (fq >> 1)) * NPROJ + C_U + g * 16 + (fq & 1) * 8); }
#pragma unroll 1
        for (int nt = 0; nt < 8; ++nt) { f32x4 acc = (f32x4){0.f, 0.f, 0.f, 0.f};
#pragma unroll
            for (int ks = 0; ks < 8; ++ks) { const bf16x8 b = *(const LAS bf16x8*)(lds + (nt * 16 + fr) * 528 + (ks * 32 + fq * 8) * 2); acc = mfma16(b, a[ks], acc); }
            *(f32x4*)(Xloc + ((size_t)(mt * 16 + fr) * 32 + g) * 128 + nt * 16 + 4 * fq) = acc; }
    }
}
__device__ void s5_scan(const Params& p) {
    const int lane = otid() & 63;
    float* Xloc = (float*)(p.ws + WS_XLOC);
    const float* a16 = (const float*)(p.ws + WS_A16);
    for (int ci = p.bid; ci < 256; ci += p.nblk) {
        const int b = ci >> 5, g = ci & 31;
        const float ar = a16[(g * 64 + lane) * 2], ai = a16[(g * 64 + lane) * 2 + 1];
        float* base = Xloc + ((size_t)(b * 258) * 32 + g) * 128 + lane;
        float sr = 0.f, si = 0.f;
        for (int c0 = 0; c0 < 258; c0 += 43) { float xr[43], xi[43];
#pragma unroll
            for (int j = 0; j < 43; ++j) { xr[j] = base[(size_t)(c0 + j) * 4096]; xi[j] = base[(size_t)(c0 + j) * 4096 + 64]; }
#pragma unroll
            for (int j = 0; j < 43; ++j) { if (!p.dry) { base[(size_t)(c0 + j) * 4096] = sr; base[(size_t)(c0 + j) * 4096 + 64] = si; }
                const float nr = ar * sr - ai * si + xr[j], ni = ar * si + ai * sr + xi[j]; sr = nr; si = ni; } }
    }
}
__device__ void s5c_item(const Params& p, int l, int item, LAS unsigned char* lds) {
    const int xcd_ = item & 7, slot_ = (item >> 3) & 31, g = xcd_ * 4 + (slot_ & 3), span = (item >> 8) * 8 + (slot_ >> 2), mt0 = span * 8, nmt = span == 15 ? 9 : 8, iters = (nmt + 7) >> 3;
    const int t = otid(), wave = t >> 6, lane = t & 63, fr = lane & 15, fq = lane >> 4;
    bf16_t* proj = (bf16_t*)(p.ws + WS_PROJ);
    const bf16_t* Wy = (const bf16_t*)(p.ws + WS_WY) + (size_t)g * 256 * 384;
    const bf16_t* Tz = (const bf16_t*)(p.ws + WS_TZ) + (size_t)g * 16 * 512;
    const float* Xin = (const float*)(p.ws + WS_XLOC);
    const f32x4 dsk = *(const f32x4*)(p.d_skip + (size_t)l * 512 + g * 16 + 4 * fq);
    for (int it = 0; it < iters; ++it) {
        const int mt = mt0 + it * 8 + wave; const bool active = mt < mt0 + nmt;
        u32x4 omf[8];
#pragma unroll
        for (int q = 0; q < 8; ++q) { const int i = t + 512 * q, r = i >> 4, c = i & 15; omf[q] = *(const u32x4*)(Wy + (size_t)r * 384 + 256 + c * 8); }
        bf16x8 tf[16];
#pragma unroll
        for (int d = 0; d < 16; ++d) tf[d] = *(const bf16x8*)(Tz + d * 512 + fr * 32 + fq * 8);
        bf16x8 a[12];
        if (active) {
#pragma unroll
            for (int ks = 0; ks < 8; ++ks) a[ks] = *(const bf16x8*)(proj + (size_t)((mt * 16 + fr) * 16 + 2 * ks + (fq >> 1)) * NPROJ + C_U + g * 16 + (fq & 1) * 8);
#pragma unroll
            for (int kk = 0; kk < 4; ++kk) { const float* xp = Xin + ((size_t)(mt * 16 + fr) * 32 + g) * 128 + kk * 32 + fq * 8; const f32x4 x0 = *(const f32x4*)xp, x1 = *(const f32x4*)(xp + 4);
                const u32x4 w = pack8(x0, x1); a[8 + kk] = *(const bf16x8*)&w; }
        } else {
#pragma unroll
            for (int ks = 0; ks < 12; ++ks) a[ks] = (bf16x8){0, 0, 0, 0, 0, 0, 0, 0};
        }
        __syncthreads();
#pragma unroll
        for (int q = 0; q < 8; ++q) { const int i = t + 512 * q, r = i >> 4, c = i & 15; *(LAS u32x4*)(lds + r * 272 + c * 16) = omf[q]; }
        u32x2 uwv[16];
        if (active) {
#pragma unroll
            for (int j = 0; j < 16; ++j) uwv[j] = *(const u32x2*)(proj + (size_t)((mt * 16 + fr) * 16 + j) * NPROJ + C_U + g * 16 + 4 * fq);
        } else {
#pragma unroll
            for (int j = 0; j < 16; ++j) uwv[j] = (u32x2){0u, 0u};
        }
        __syncthreads();
        if (active) {
#pragma unroll
            for (int j = 0; j < 16; ++j) { f32x4 acc = (f32x4){0.f, 0.f, 0.f, 0.f};
#pragma unroll
                for (int ks = 0; ks < 8; ++ks) if (ks <= (j >> 1)) acc = mfma16(tf[j - 2 * ks], a[ks], acc);
#pragma unroll
                for (int kk = 0; kk < 4; ++kk) { const bf16x8 b = *(const LAS bf16x8*)(lds + (j * 16 + fr) * 272 + (kk * 32 + fq * 8) * 2); acc = mfma16(b, a[8 + kk], acc); }
                bf16_t* up = proj + (size_t)((mt * 16 + fr) * 16 + j) * NPROJ + C_U + g * 16 + 4 * fq;
                const u32x2 uw = uwv[j];
                const float y0 = acc[0] + dsk[0] * bflo(uw.x), y1 = acc[1] + dsk[1] * bfhi(uw.x), y2 = acc[2] + dsk[2] * bflo(uw.y), y3 = acc[3] + dsk[3] * bfhi(uw.y);
                u32x2 ow; ow.x = cvt_pk_bf16(gelu_tanh(y0), gelu_tanh(y1)); ow.y = cvt_pk_bf16(gelu_tanh(y2), gelu_tanh(y3));
                if (!p.dry) *(u32x2*)up = ow;
                __builtin_amdgcn_sched_barrier(0); }
        }
    }
}

constexpr int GLA_ITEMS = NBATCH * 4 * (GCH / 2);
constexpr int GL_QD = 0, GL_KI = 9216, GL_P = 18432, GL_VT = 27648, GL_SEG = 46080, GL_HALF = 47104;
struct GlaLoads { unsigned short xl[16], xk[16], xq[16], vv[4][8]; };
__device__ __forceinline__ void gla_issue_loads(GlaLoads& L, const bf16_t* proj, int b, int h, int n, int dk, int seg, int t4, bool want_q) {
#pragma unroll
    for (int i = 0; i < 16; ++i) { const int rb = n * 64 + seg * 16 + i, rc = rb < TB ? rb : TB - 1; const bf16_t* rp = proj + (size_t)(b * TB + rc) * NPROJ + h * 64 + dk;
        L.xl[i] = rp[C_GL]; L.xk[i] = rp[C_K]; if (want_q) L.xq[i] = rp[C_Q]; }
#pragma unroll
    for (int q = 0; q < 4; ++q) { const int task = t4 + 256 * q, dv = task & 127, rg = task >> 7;
#pragma unroll
        for (int j = 0; j < 8; ++j) { const int rb = n * 64 + rg * 8 + j, rc = rb < TB ? rb : TB - 1; L.vv[q][j] = proj[(size_t)(b * TB + rc) * NPROJ + C_V + h * 128 + dv]; } }
}
__device__ __forceinline__ float gla_cumsum(const Params& p, int l, const GlaLoads& L, int h, int n, int dk, int seg, LAS unsigned char* hl, float (&bc)[16]) {
    const float ba = p.b_alpha[(size_t)l * 256 + h * 64 + dk]; float run = 0.f;
#pragma unroll
    for (int i = 0; i < 16; ++i) { const int rb = n * 64 + seg * 16 + i; const float la = rb < TB ? logsigmoidf_(bf2f(L.xl[i]) + ba) * (1.0f / 16.0f) : 0.f;
        run += la; bc[i] = run; }
    LAS float* segs = (LAS float*)(hl + GL_SEG);
    segs[seg * 64 + dk] = run;
    __syncthreads();
    float pre = 0.f, tot = 0.f;
#pragma unroll
    for (int s = 0; s < 4; ++s) { const float v = segs[s * 64 + dk]; tot += v; if (s < seg) pre += v; }
#pragma unroll
    for (int i = 0; i < 16; ++i) bc[i] += pre;
    return tot;
}
__device__ __forceinline__ void gla_store_vT(const GlaLoads& L, int n, int t4, LAS unsigned char* hl) {
#pragma unroll
    for (int q = 0; q < 4; ++q) { const int task = t4 + 256 * q, dv = task & 127, rg = task >> 7; unsigned v[8];
#pragma unroll
        for (int j = 0; j < 8; ++j) { const int rb = n * 64 + rg * 8 + j; v[j] = rb < TB ? (unsigned)L.vv[q][j] : 0u; }
        u32x4 w; w.x = v[0] | (v[1] << 16); w.y = v[2] | (v[3] << 16); w.z = v[4] | (v[5] << 16); w.w = v[6] | (v[7] << 16);
        *(LAS u32x4*)(hl + GL_VT + dv * 144 + rg * 16) = w; }
}
__device__ void gla1_item(const Params& p, int l, int item, LAS unsigned char* lds) {
    const int t = otid(), half = t >> 8, t4 = t & 255, wv = (t >> 6) & 3, lane = t & 63, fr = lane & 15, fq = lane >> 4;
    const int pair = item % (GCH / 2), bh = item / (GCH / 2), b = bh >> 2, h = bh & 3, n = pair * 2 + half;
    const bf16_t* proj = (const bf16_t*)(p.ws + WS_PROJ);
    LAS unsigned char* hl = lds + half * GL_HALF;
    const int dk = t4 & 63, seg = t4 >> 6;
    GlaLoads L; gla_issue_loads(L, proj, b, h, n, dk, seg, t4, false);
    __syncthreads();
    float bc[16];
    const float tot = gla_cumsum(p, l, L, h, n, dk, seg, hl, bc);
    { unsigned w[8];
#pragma unroll
      for (int i = 0; i < 16; i += 2) { const int rb = n * 64 + seg * 16 + i;
          const float k0 = rb < TB ? bf2f(L.xk[i]) * __expf(tot - bc[i]) : 0.f, k1 = rb + 1 < TB ? bf2f(L.xk[i + 1]) * __expf(tot - bc[i + 1]) : 0.f;
          w[i >> 1] = cvt_pk_bf16(k0, k1); }
      *(LAS u32x4*)(hl + GL_KI + dk * 144 + seg * 32) = (u32x4){w[0], w[1], w[2], w[3]};
      *(LAS u32x4*)(hl + GL_KI + dk * 144 + seg * 32 + 16) = (u32x4){w[4], w[5], w[6], w[7]}; }
    gla_store_vT(L, n, t4, hl);
    if (seg == 0) ((float*)(p.ws + WS_DECAY))[((size_t)bh * GCH + n) * 64 + dk] = __expf(tot);
    __syncthreads();
    bf16_t* kvT = (bf16_t*)((unsigned char*)p.out + OS_KVT) + ((size_t)bh * GCH + n) * 8192;
#pragma unroll
    for (int mt = 0; mt < 2; ++mt) { const int dv0 = wv * 32 + mt * 16;
        bf16x8 rf[2];
#pragma unroll
        for (int ks = 0; ks < 2; ++ks) rf[ks] = *(const LAS bf16x8*)(hl + GL_VT + (dv0 + fr) * 144 + (ks * 32 + fq * 8) * 2);
#pragma unroll
        for (int nt = 0; nt < 4; ++nt) { f32x4 acc = (f32x4){0.f, 0.f, 0.f, 0.f};
#pragma unroll
            for (int ks = 0; ks < 2; ++ks) { const bf16x8 cf = *(const LAS bf16x8*)(hl + GL_KI + (nt * 16 + fr) * 144 + (ks * 32 + fq * 8) * 2); acc = mfma16(cf, rf[ks], acc); }
            u32x2 w; w.x = cvt_pk_bf16(acc[0], acc[1]); w.y = cvt_pk_bf16(acc[2], acc[3]);
            *(u32x2*)(kvT + (dv0 + fr) * 64 + nt * 16 + 4 * fq) = w; } }
}
__device__ void gla_scan(const Params& p) {
    const int tt = otid() - 64;
    if (tt < 0 || tt >= 256) return;
    bf16_t* kvT = (bf16_t*)((unsigned char*)p.out + OS_KVT);
    const float* decay = (const float*)(p.ws + WS_DECAY);
    for (int blk = p.bid; blk < 256; blk += p.nblk) {
        const int qi = blk * 256 + tt, bh = qi >> 11, rem = qi & 2047, dv = rem >> 4, dkq = rem & 15;
        bf16_t* kp = kvT + (size_t)bh * GCH * 8192 + dv * 64 + dkq * 4; const float* dp = decay + (size_t)bh * GCH * 64 + dkq * 4;
        f32x4 S = (f32x4){0.f, 0.f, 0.f, 0.f};
        for (int n0 = 0; n0 < 65; n0 += 13) { u32x2 w[13]; f32x4 d[13];
#pragma unroll
            for (int j = 0; j < 13; ++j) { w[j] = *(const u32x2*)(kp + (size_t)(n0 + j) * 8192); d[j] = *(const f32x4*)(dp + (n0 + j) * 64); }
#pragma unroll
            for (int j = 0; j < 13; ++j) { u32x2 o; o.x = cvt_pk_bf16(S[0], S[1]); o.y = cvt_pk_bf16(S[2], S[3]); if (!p.dry) *(u32x2*)(kp + (size_t)(n0 + j) * 8192) = o;
                S = d[j] * S + (f32x4){bflo(w[j].x), bfhi(w[j].x), bflo(w[j].y), bfhi(w[j].y)}; } }
    }
}
__device__ void gla3_item(const Params& p, int l, int item, LAS unsigned char* lds) {
    const int t = otid(), half = t >> 8, t4 = t & 255, wv = (t >> 6) & 3, lane = t & 63, fr = lane & 15, fq = lane >> 4;
    const int pair = item % (GCH / 2), bh = item / (GCH / 2), b = bh >> 2, h = bh & 3, n = pair * 2 + half;
    bf16_t* proj = (bf16_t*)(p.ws + WS_PROJ);
    LAS unsigned char* hl = lds + half * GL_HALF;
    const int dk = t4 & 63, seg = t4 >> 6;
    GlaLoads L; gla_issue_loads(L, proj, b, h, n, dk, seg, t4, true);
    const bf16_t* spT = (const bf16_t*)((const unsigned char*)p.out + OS_KVT) + ((size_t)bh * GCH + n) * 8192;
    bf16x8 spf[8][2];
#pragma unroll
    for (int nt = 0; nt < 8; ++nt)
#pragma unroll
        for (int ks = 0; ks < 2; ++ks) spf[nt][ks] = *(const bf16x8*)(spT + (nt * 16 + fr) * 64 + ks * 32 + fq * 8);
    const int rb = n * 64 + wv * 16 + fr, rbc = rb < TB ? rb : TB - 1;
    bf16_t* rowp = proj + (size_t)(b * TB + rbc) * NPROJ;
    u32x2 rwv[8];
#pragma unroll
    for (int nt = 0; nt < 8; ++nt) rwv[nt] = *(const u32x2*)(rowp + C_R + h * 128 + nt * 16 + 4 * fq);
    __syncthreads();
    float bc[16];
    (void)gla_cumsum(p, l, L, h, n, dk, seg, hl, bc);
#pragma unroll
    for (int i = 0; i < 16; ++i) { const int rbi = n * 64 + seg * 16 + i, row = seg * 16 + i;
        const float qv = rbi < TB ? bf2f(L.xq[i]) * 0.125f * __expf(bc[i]) : 0.f, kv = rbi < TB ? bf2f(L.xk[i]) * __expf(-bc[i]) : 0.f;
        *(LAS bf16_t*)(hl + GL_QD + row * 144 + dk * 2) = f2bf(qv); *(LAS bf16_t*)(hl + GL_KI + row * 144 + dk * 2) = f2bf(kv); }
    gla_store_vT(L, n, t4, hl);
    __syncthreads();
    bf16x8 qf[2];
#pragma unroll
    for (int ks = 0; ks < 2; ++ks) qf[ks] = *(const LAS bf16x8*)(hl + GL_QD + (wv * 16 + fr) * 144 + (ks * 32 + fq * 8) * 2);
#pragma unroll
    for (int st = 0; st < 4; ++st) { f32x4 acc = (f32x4){0.f, 0.f, 0.f, 0.f};
        if (st <= wv) {
#pragma unroll
            for (int ks = 0; ks < 2; ++ks) { const bf16x8 cf = *(const LAS bf16x8*)(hl + GL_KI + (st * 16 + fr) * 144 + (ks * 32 + fq * 8) * 2); acc = mfma16(cf, qf[ks], acc); }
            const int c = wv * 16 + fr, s0 = st * 16 + 4 * fq;
#pragma unroll
            for (int r = 0; r < 4; ++r) if (s0 + r > c) acc[r] = 0.f;
        }
        u32x2 w; w.x = cvt_pk_bf16(acc[0], acc[1]); w.y = cvt_pk_bf16(acc[2], acc[3]);
        *(LAS u32x2*)(hl + GL_P + (wv * 16 + fr) * 144 + (st * 16 + 4 * fq) * 2) = w; }
    __syncthreads();
    bf16x8 pf[2];
#pragma unroll
    for (int ks = 0; ks < 2; ++ks) pf[ks] = *(const LAS bf16x8*)(hl + GL_P + (wv * 16 + fr) * 144 + (ks * 32 + fq * 8) * 2);
    f32x4 o[8]; float ss = 0.f;
#pragma unroll
    for (int nt = 0; nt < 8; ++nt) { f32x4 acc = (f32x4){0.f, 0.f, 0.f, 0.f};
#pragma unroll
        for (int ks = 0; ks < 2; ++ks) { const bf16x8 cf = *(const LAS bf16x8*)(hl + GL_VT + (nt * 16 + fr) * 144 + (ks * 32 + fq * 8) * 2); acc = mfma16(cf, pf[ks], acc); }
#if !MK_NO_INTER
#pragma unroll
        for (int ks = 0; ks < 2; ++ks) acc = mfma16(spf[nt][ks], qf[ks], acc);
#endif
        o[nt] = acc; ss += acc[0] * acc[0] + acc[1] * acc[1] + acc[2] * acc[2] + acc[3] * acc[3]; }
    ss += shx(ss, lane, 16); ss += shx(ss, lane, 32);
    const float rstd = rsqrtf(ss * (1.0f / 128.0f) + EPS);
    if (rb < TB) { const float* gn = p.gla_norm + (size_t)l * 512 + h * 128;
#pragma unroll
        for (int nt = 0; nt < 8; ++nt) { const int dv = nt * 16 + 4 * fq; const f32x4 gv = *(const f32x4*)(gn + dv); const u32x2 rw = rwv[nt];
            const float v0 = o[nt][0] * rstd * gv[0] * siluf_(bflo(rw.x)), v1 = o[nt][1] * rstd * gv[1] * siluf_(bfhi(rw.x)),
                        v2 = o[nt][2] * rstd * gv[2] * siluf_(bflo(rw.y)), v3 = o[nt][3] * rstd * gv[3] * siluf_(bfhi(rw.y));
            u32x2 w; w.x = cvt_pk_bf16(v0, v1); w.y = cvt_pk_bf16(v2, v3); if (!p.dry) *(u32x2*)(rowp + C_V + h * 128 + dv) = w; } }
}

__device__ __forceinline__ int mix_item(int r, int bid, int nblk) {
    const int pos = r * nblk + ((r & 1) ? nblk - 1 - bid : bid);
    if (pos >= S5_ITEMS + GLA_ITEMS) return -1;
    if (pos < 32) return 480 + pos;
    if (pos < S5_ITEMS) return pos - 32;
    return pos;
}
__device__ void tail_glu(const Params& p, int l, LAS unsigned char* lds) {
    const int t = otid(), w = t >> 6, lane = t & 63, fr = lane & 15, fq = lane >> 4, nt = w & 1, kq = w >> 1;
    bf16_t* proj = (bf16_t*)(p.ws + WS_PROJ); const bf16_t* Bt = (const bf16_t*)(p.ws + WS_W) + W_GLU;
    for (int piece = p.bid; piece < 256; piece += p.nblk) {
        const int row = MP - 256 + (piece >> 4) * 16 + fr, colw = (piece & 15) * 32 + nt * 16;
        bf16x8 a[4], b[4];
#pragma unroll
        for (int ks = 0; ks < 4; ++ks) { a[ks] = *(const bf16x8*)(proj + (size_t)row * NPROJ + C_U + kq * 128 + ks * 32 + fq * 8); b[ks] = *(const bf16x8*)(Bt + (size_t)(colw + fr) * 512 + kq * 128 + ks * 32 + fq * 8); }
        const int col = colw + 4 * fq;
        const u32x2 aw = *(const u32x2*)(proj + (size_t)row * NPROJ + C_U + col); const f32x4 bias = *(const f32x4*)(p.b_glu + (size_t)l * 512 + col);
        f32x4 acc = (f32x4){0.f, 0.f, 0.f, 0.f};
#pragma unroll
        for (int ks = 0; ks < 4; ++ks) acc = mfma16(b[ks], a[ks], acc);
        __syncthreads();
        *(LAS f32x4*)(lds + (w * 64 + lane) * 16) = acc;
        __syncthreads();
        if (w < 2) { f32x4 s = acc;
#pragma unroll
            for (int q = 1; q < 4; ++q) s += *(const LAS f32x4*)(lds + ((nt + 2 * q) * 64 + lane) * 16);
            const f32x4 act = (f32x4){bflo(aw.x), bfhi(aw.x), bflo(aw.y), bfhi(aw.y)}, o = act * sig4(s + bias);
            u32x2 ow; ow.x = cvt_pk_bf16(o[0], o[1]); ow.y = cvt_pk_bf16(o[2], o[3]); *(u32x2*)(proj + (size_t)row * NPROJ + C_GLU + col) = ow; }
    }
    __syncthreads();
}
__device__ void tail_mix(const Params& p, LAS unsigned char* lds) {
    const int t = otid(), w = t >> 6, lane = t & 63, fr = lane & 15, fq = lane >> 4, nt = w & 3, which = w >> 2;
    const bf16_t* proj = (const bf16_t*)(p.ws + WS_PROJ); const bf16_t* Bt = (const bf16_t*)(p.ws + WS_W) + (which ? W_PB : W_PA);
    bf16_t* mixed = (bf16_t*)((unsigned char*)p.out + OS_Z);
    for (int piece = p.bid; piece < 256; piece += p.nblk) {
        const int row = MP - 256 + (piece >> 4) * 16 + fr, colw = (piece & 15) * 64 + nt * 16, col = colw + 4 * fq;
        const bf16_t* ap = proj + (size_t)row * NPROJ + (which ? C_V : C_GLU); const bf16_t* bp = Bt + (size_t)(colw + fr) * 512;
        const u32x2 gaw = *(const u32x2*)(proj + (size_t)row * NPROJ + C_GA + col), gbw = *(const u32x2*)(proj + (size_t)row * NPROJ + C_GB + col);
        f32x4 acc = (f32x4){0.f, 0.f, 0.f, 0.f};
#pragma unroll
        for (int half = 0; half < 2; ++half) { bf16x8 a[8], b[8];
#pragma unroll
            for (int ks = 0; ks < 8; ++ks) { a[ks] = *(const bf16x8*)(ap + half * 256 + ks * 32 + fq * 8); b[ks] = *(const bf16x8*)(bp + half * 256 + ks * 32 + fq * 8); }
#pragma unroll
            for (int ks = 0; ks < 8; ++ks) acc = mfma16(b[ks], a[ks], acc); }
        __syncthreads();
        if (which) *(LAS f32x4*)(lds + (nt * 64 + lane) * 16) = acc;
        __syncthreads();
        if (!which) { const f32x4 accb = *(const LAS f32x4*)(lds + (nt * 64 + lane) * 16);
            const f32x4 ga = (f32x4){bflo(gaw.x), bfhi(gaw.x), bflo(gaw.y), bfhi(gaw.y)}, gb = (f32x4){bflo(gbw.x), bfhi(gbw.x), bflo(gbw.y), bfhi(gbw.y)};
            const f32x4 o = acc * sig4(ga) + accb * sig4(gb);
            u32x2 ow; ow.x = cvt_pk_bf16(o[0], o[1]); ow.y = cvt_pk_bf16(o[2], o[3]); *(u32x2*)(mixed + (size_t)row * DM + col) = ow; }
    }
    __syncthreads();
}

#define XB_TMO      128
#define XB_XCNT(j)  (256  + 64 * (j))
#define XB_XSUB(j)  (1280 + 64 * (j))
#define XB_XGEN(j)  (2304 + 64 * (j))
#define XB_TOP      3328
#define XB_TOPGEN   3392
#define XCD_BAR_WORDS 3456
#define XB_SPIN_CAP (1u << 20)
__device__ __forceinline__ unsigned xb_ld(unsigned* p)              { return __hip_atomic_load(p, __ATOMIC_RELAXED, __HIP_MEMORY_SCOPE_AGENT); }
__device__ __forceinline__ unsigned xb_add(unsigned* p, unsigned v) { return __hip_atomic_fetch_add(p, v, __ATOMIC_RELAXED, __HIP_MEMORY_SCOPE_AGENT); }
__device__ __forceinline__ unsigned xb_xcc_id() { return (unsigned)__builtin_amdgcn_s_getreg((3 << 11) | 20) & 0xFu; }
#define XB_SPIN(cond, bar) do { unsigned _sp = 0; while (cond) { __builtin_amdgcn_s_sleep(1); \
    if ((++_sp & 255u) == 0u) { if (xb_ld(&(bar)[XB_TMO])) break; if (_sp > XB_SPIN_CAP) { atomicAdd(&(bar)[XB_TMO], 1u); break; } } } } while (0)
struct XcdBarrier { unsigned* bar; unsigned x; volatile LAS unsigned* st; };
__device__ __forceinline__ XcdBarrier xcd_barrier_post(unsigned* bar, volatile LAS unsigned* st) {
    XcdBarrier b; b.bar = bar; b.x = xb_xcc_id(); b.st = st;
    if (threadIdx.x == 0) (void)xb_add(&bar[XB_XCNT(b.x)], 1u);
    return b;
}
__device__ __forceinline__ void xcd_barrier_complete(unsigned* bar, unsigned x, unsigned& nloc, unsigned& nx) {
    const unsigned G = gridDim.x * gridDim.y * gridDim.z;
    unsigned sum, cnt, mine, sp = 0u;
    for (;;) {
        sum = 0u; cnt = 0u; mine = 0u;
#pragma unroll
        for (unsigned j = 0; j < 16; ++j) { const unsigned c = xb_ld(&bar[XB_XCNT(j)]); sum += c; cnt += (c > 0u) ? 1u : 0u; mine = (j == x) ? c : mine; }
        if (sum == G) break;
        __builtin_amdgcn_s_sleep(1);
        if ((++sp & 255u) == 0u) { if (xb_ld(&bar[XB_TMO])) break; if (sp > XB_SPIN_CAP) { atomicAdd(&bar[XB_TMO], 1u); break; } }
    }
    nloc = mine > 0u ? mine : 1u; nx = cnt > 0u ? cnt : 1u;
}
__device__ __forceinline__ void xcd_barrier(const XcdBarrier& b) {
    asm volatile("s_waitcnt vmcnt(0)" ::: "memory");
    __syncthreads();
    if (threadIdx.x == 0) {
        unsigned* bar = b.bar;
        __builtin_amdgcn_s_waitcnt(0);
        unsigned nloc = b.st[0], nx = b.st[1];
        if (nloc == 0u) { xcd_barrier_complete(bar, b.x, nloc, nx); b.st[0] = nloc; b.st[1] = nx; }
        const unsigned old = xb_add(&bar[XB_XSUB(b.x)], 1u);
        const unsigned gen = old / nloc;
        if (old + 1u == (gen + 1u) * nloc) {
            __builtin_amdgcn_fence(__ATOMIC_RELEASE, "agent");
            asm volatile("s_waitcnt vmcnt(0)" ::: "memory");
            const unsigned og = xb_add(&bar[XB_TOP], 1u);
            const unsigned tg = og / nx;
            if (og + 1u == (tg + 1u) * nx) xb_add(&bar[XB_TOPGEN], 1u);
            else XB_SPIN(xb_ld(&bar[XB_TOPGEN]) == tg, bar);
            __builtin_amdgcn_fence(__ATOMIC_ACQUIRE, "agent");
            xb_add(&bar[XB_XGEN(b.x)], 1u);
            asm volatile("s_waitcnt vmcnt(0)" ::: "memory");
        } else {
            XB_SPIN(xb_ld(&bar[XB_XGEN(b.x)]) == gen, bar);
            __builtin_amdgcn_fence(__ATOMIC_ACQUIRE, "agent");
            asm volatile("s_waitcnt vmcnt(0)" ::: "memory");
        }
    }
    __syncthreads();
}

constexpr int NPHASE = 2 + 11 * DEPTH;
__device__ void run_phase(const Params& p, int ph, LAS unsigned char* lds) {
    bf16_t* hres = (bf16_t*)(p.ws + WS_H);
    bf16_t* proj = (bf16_t*)(p.ws + WS_PROJ);
    bf16_t* W = (bf16_t*)(p.ws + WS_W);
    bf16_t* z = (bf16_t*)((unsigned char*)p.out + OS_Z);
    bf16_t* hy = (bf16_t*)(p.ws + WS_Y);
    float* ssq1 = (float*)(p.ws + WS_SSQ1); float* ssq2 = (float*)(p.ws + WS_SSQ2); float* rs1 = (float*)(p.ws + WS_RS1); float* rs2 = (float*)(p.ws + WS_RS2);
    float* ldsf = (float*)(unsigned char*)lds;
    pg8::StaticOrder S;
    if (ph == 0) {
        for (int it = p.bid; it < NCONV_MIX + 256; it += p.nblk) { if (it < NCONV_MIX) conv_mixer_item(p, 0, it, ldsf); else s5_prep_item(p, 0, it - NCONV_MIX, ldsf); }
        init_h(p); return; }
    if (ph == NPHASE - 1) { final_norm(p, hres, p.norm_f, p.out); return; }
    const int l = (ph - 1) / 11, s = (ph - 1) % 11;
    if (l >= MK_LAYERS || s > MK_LAST_S) return;
    switch (s) {
    case 0:
        if (l > 0) fold_rows(p, 11, ssq1, rs1);
        break;
    case 1: { S.init(MP, NPROJ, 1024, p.nblk, p.bid); pg8::gemm_phase(lds, pg8::Gemm{hres, W + W_IN, MP, NPROJ, 1024, 1024, nullptr, nullptr}, S, EpiStore{proj, NPROJ, rs1}); }
        { const int first = (MP / 256 * (NPROJ / 256)) % p.nblk;
          if (p.bid >= first && first > 0) for (int it = p.bid - first; it < 352; it += p.nblk - first) conv_ff_item(p, l, it, ldsf); else if (first == 0) for (int it = p.bid; it < 352; it += p.nblk) conv_ff_item(p, l, it, ldsf); }
        break;
    case 2:
        for (int it = p.bid; it < S5_ITEMS + GLA_ITEMS; it += p.nblk) { if (it < S5_ITEMS) s5a_item(p, it, lds); else gla1_item(p, l, it - S5_ITEMS, lds); }
        break;
    case 3:
        if (otid() < 64) s5_scan(p);
#if !MK_NO_GSCAN
        else gla_scan(p);
#endif
        break;
    case 4:
        for (int it = p.bid; it < S5_ITEMS + GLA_ITEMS; it += p.nblk) { if (it < S5_ITEMS) s5c_item(p, l, it, lds); else gla3_item(p, l, it - S5_ITEMS, lds); }
        break;
    case 5: { tail_glu(p, l, lds); S.init(MP - 256, 512, 512, p.nblk, p.bid); pg8::gemm_phase(lds, pg8::Gemm{proj + C_U, W + W_GLU, MP - 256, 512, 512, NPROJ, nullptr, nullptr}, S, EpiGlu{proj, p.b_glu + (size_t)l * 512}); }
        if (l + 1 < DEPTH) for (int it = p.bid; it < 256; it += p.nblk) s5_prep_item(p, l + 1, it, ldsf);
        break;
    case 6: { tail_mix(p, lds); S.init(MP - 256, 1024, 512, p.nblk, p.bid, 0, 1);
        pg8::gemm_phase(lds, pg8::Gemm{proj + C_GLU, W + W_PA, MP - 256, 1024, 512, NPROJ, proj + C_V, W + W_PB}, S, EpiMixPair{proj + C_GA, proj + C_GB, z}); } break;
    case 7: { S.init(MP, 1024, 1024, p.nblk, p.bid, 4); pg8::gemm_phase(lds, pg8::Gemm{z, W + W_OUT, MP, 1024, 1024, 1024, nullptr, nullptr}, S, EpiRes{hres, p.dry ? 0.f : 1.f, (float*)(p.ws + WS_PART), ssq2}); }
        break;
    case 8:
        fold_rows(p, 4, ssq2, rs2); break;
    case 9: { S.init(MP, 2 * DFF, 1024, p.nblk, p.bid); pg8::gemm_phase(lds, pg8::Gemm{hres, W + W_FF13, MP, 2 * DFF, 1024, 1024, nullptr, nullptr}, S, EpiFF{proj, rs2}); }
        { const int first = (MP / 256 * (2 * DFF / 256)) % p.nblk, nmix = l + 1 < DEPTH ? NCONV_MIX : 0;
          const int i0 = first > 0 ? p.bid - first : p.bid, st = first > 0 ? p.nblk - first : p.nblk;
          if (i0 >= 0) for (int it = i0; it < nmix + 176; it += st) { if (it < nmix) conv_mixer_item(p, l + 1, it, ldsf); else conv_ff_item(p, l, 352 + it - nmix, ldsf); } }
        break;
    case 10: { S.init(MP, 1024, DFF, p.nblk, p.bid, 11); pg8::gemm_phase(lds, pg8::Gemm{proj, W + W_FF2, MP, 1024, DFF, DFF, nullptr, nullptr}, S, EpiRes{hres, p.dry ? 0.f : 1.f, (float*)(p.ws + WS_PART), ssq1}); }
        break;
    }
}

typedef const float* fptr_t;
typedef __attribute__((address_space(4))) const fptr_t kfptr_t;
__global__ void __launch_bounds__(512, 2) hybrid_fwd(Params p0) {
    extern __shared__ __attribute__((aligned(16))) unsigned char shm[];
    LAS unsigned char* lds = (LAS unsigned char*)shm;
    cg::grid_group grid = cg::this_grid();
    const int ph_lo = p0.ph_lo, ph_hi = p0.ph_hi;
    volatile LAS unsigned* xst = (volatile LAS unsigned*)(lds + 131072);
    if (threadIdx.x == 0) { xst[0] = 0u; xst[1] = 0u; }
    __syncthreads();
    XcdBarrier xb = xcd_barrier_post((unsigned*)(p0.ws + WS_BAR), xst);
    for (int ph = ph_lo; ph < ph_hi; ++ph) {
        if (ph == 1 && MK_ONE_LAUNCH) continue;
        int reps = (MK_DUP >= 0 && ph >= 1 && ph < NPHASE - 1 && (ph - 1) % 11 == MK_DUP) ? 2 : 1;
        for (int rep = 0; rep < reps; ++rep) {
        kfptr_t* tab = (kfptr_t*)__builtin_amdgcn_kernarg_segment_ptr(); asm volatile("" : "+s"(tab));
        Params p;
        p.x = tab[0]; p.meta = tab[1]; p.norm1 = tab[2]; p.w_in = tab[3]; p.lam_re = tab[4]; p.lam_im = tab[5]; p.log_step = tab[6]; p.b_re = tab[7]; p.b_im = tab[8];
        p.c_re = tab[9]; p.c_im = tab[10]; p.d_skip = tab[11]; p.w_glu = tab[12]; p.b_glu = tab[13]; p.w_pa = tab[14]; p.w_alpha = tab[15]; p.b_alpha = tab[16];
        p.gla_norm = tab[17]; p.w_pb = tab[18]; p.w_out = tab[19]; p.norm2 = tab[20]; p.w_ff1 = tab[21]; p.w_ff3 = tab[22]; p.w_ff2 = tab[23]; p.norm_f = tab[24];
        p.out = (float*)tab[25]; p.ws = (unsigned char*)tab[26]; p.ph_lo = ph_lo; p.ph_hi = ph_hi;
        int bid = blockIdx.x, nblk = gridDim.x; asm volatile("" : "+s"(bid)); asm volatile("" : "+s"(nblk));
        p.bid = bid; p.nblk = nblk; p.dry = (reps == 2 && rep == 0 && MK_DUP_DRY) ? 1 : 0; p.pad_ = 0;
        run_phase(p, ph, lds);
        if (rep + 1 < reps || ph + 1 < ph_hi) {
            if (ph == ph_lo && rep == 0) grid.sync();
            else { xb.bar = (unsigned*)(p.ws + WS_BAR); xcd_barrier(xb); } }
        if (MK_DUP == 99) { xb.bar = (unsigned*)(p.ws + WS_BAR); xcd_barrier(xb); }
        }
    }
}

extern "C" void kernel_launch(void* const* d_in, const int* in_sizes, int n_in, void* d_out, int out_size, void* d_ws, size_t ws_size, hipStream_t stream) {
    static int grid = 0;
    if (grid == 0) {
        if (n_in != 25 || ws_size < WS_END) { fprintf(stderr, "kernel_launch: unexpected n_in %d or ws_size %zu (< %zu)\n", n_in, ws_size, (size_t)WS_END); grid = -1; return; }
        int dev = 0, cus = 0, per_cu = 0;
        hipGetDevice(&dev); hipDeviceGetAttribute(&cus, hipDeviceAttributeMultiprocessorCount, dev);
        if (hipFuncSetAttribute((const void*)hybrid_fwd, hipFuncAttributeMaxDynamicSharedMemorySize, LDS_BYTES) != hipSuccess) { fprintf(stderr, "kernel_launch: hipFuncSetAttribute failed\n"); grid = -1; return; }
        if (hipOccupancyMaxActiveBlocksPerMultiprocessor(&per_cu, (const void*)hybrid_fwd, 512, LDS_BYTES) != hipSuccess || per_cu < 1) { fprintf(stderr, "kernel_launch: occupancy query says %d\n", per_cu); per_cu = 1; }
        (void)hipGetLastError();
        grid = cus * per_cu;
    }
    if (grid < 0) return;
    Params p{};
    const float** pp = (const float**)&p;
    for (int i = 0; i < 25; ++i) pp[i] = (const float*)d_in[i];
    p.out = (float*)d_out; p.ws = (unsigned char*)d_ws;
#if MK_ONE_LAUNCH
    p.ph_lo = 0; p.ph_hi = NPHASE;
    (void)hipMemsetAsync((char*)d_ws + WS_BAR, 0, 16384, stream);
    void* args[] = {&p};
    hipError_t e = hipLaunchCooperativeKernel((const void*)hybrid_fwd, dim3(grid), dim3(512), args, LDS_BYTES, stream);
    if (e != hipSuccess) fprintf(stderr, "cooperative launch failed: %s (grid %d)\n", hipGetErrorString(e), grid);
#else
    for (int ph = 0; ph < NPHASE; ++ph) { p.ph_lo = ph; p.ph_hi = ph + 1; hipLaunchKernelGGL(hybrid_fwd, dim3(grid), dim3(512), LDS_BYTES, stream, p); }
#endif
}
```

```cpp
#include <hip/hip_runtime.h>
#include <hip/hip_cooperative_groups.h>
#include <cstdio>
namespace cg = cooperative_groups;

#ifndef MK_DRY_S5ONLY
#define MK_DRY_S5ONLY 0
#endif
#ifndef MK_DUP_DRY
#define MK_DUP_DRY 0
#endif
#ifndef MK_DUP
#define MK_DUP -1
#endif
#ifndef MK_NO_GSCAN
#define MK_NO_GSCAN 0
#endif
#ifndef MK_NO_INTER
#define MK_NO_INTER 0
#endif
#ifndef MK_BRANCH
#define MK_BRANCH 0
#endif
#ifndef MK_LAYERS
#define MK_LAYERS 4
#endif
#ifndef MK_LAST_S
#define MK_LAST_S 10
#endif
#ifndef MK_ONE_LAUNCH
#define MK_ONE_LAUNCH 1
#endif

#define LAS __attribute__((address_space(3)))
typedef unsigned short bf16_t;
typedef short bf16x8 __attribute__((ext_vector_type(8)));
typedef float f32x4 __attribute__((ext_vector_type(4)));
typedef float f32x2 __attribute__((ext_vector_type(2)));
typedef unsigned u32x4 __attribute__((ext_vector_type(4)));
typedef unsigned u32x2 __attribute__((ext_vector_type(2)));

constexpr int DM = 1024, NBATCH = 8, SEQ = 4096, NMETA = 16, DEPTH = 4;
constexpr int TB = 4128;
constexpr int MP = NBATCH * TB;
constexpr int NPROJ = 4352;
constexpr int DFF = 2816;
constexpr int C_U = 0, C_Q = 512, C_K = 768, C_V = 1024, C_R = 1536, C_GL = 2048, C_GA = 2304, C_GB = 3328;
constexpr int C_GLU = 512;
constexpr int NCH16 = MP / 16;
constexpr int GCH = 66;
constexpr float EPS = 1e-6f;

constexpr size_t WS_H = 0;
constexpr size_t WS_PROJ = WS_H + (size_t)MP * DM * 4;
constexpr size_t WS_W = WS_PROJ + (size_t)MP * NPROJ * 2 + 65536;
constexpr size_t W_IN = 0, W_GLU = W_IN + (size_t)NPROJ * 1024, W_PA = W_GLU + 512 * 512, W_PB = W_PA + 1024 * 512, W_OUT = W_PB + 1024 * 512,
                 W_FF13 = W_OUT + 1024 * 1024, W_FF2 = W_FF13 + (size_t)2 * DFF * 1024, W_END = W_FF2 + (size_t)1024 * DFF;
constexpr size_t WS_XLOC = WS_W + W_END * 2;
constexpr size_t WS_WY = WS_XLOC + (size_t)NCH16 * 32 * 128 * 4;
constexpr size_t WS_WE = WS_WY + (size_t)32 * 256 * 384 * 2;
constexpr size_t WS_A16 = WS_WE + (size_t)32 * 128 * 256 * 2;
constexpr size_t WS_DECAY = WS_A16 + 32 * 64 * 2 * 4;
constexpr size_t WS_PART = WS_DECAY + (size_t)32 * GCH * 64 * 4;
constexpr size_t WS_BAR = WS_PART + (size_t)11 * 256 * 1024 * 4;
constexpr size_t WS_SSQ1 = WS_BAR + 16384;
constexpr size_t WS_SSQ2 = WS_SSQ1 + (size_t)MP * 16 * 4;
constexpr size_t WS_RS1 = WS_SSQ2 + (size_t)MP * 16 * 4;
constexpr size_t WS_RS2 = WS_RS1 + (size_t)MP * 4;
constexpr size_t WS_TZ = WS_RS2 + (size_t)MP * 4;
constexpr size_t WS_END = WS_TZ + (size_t)32 * 16 * 512 * 2;
constexpr size_t WS_Y = WS_PROJ + (size_t)MP * DFF * 2;
constexpr size_t OS_Z = 0;
constexpr size_t OS_KVT = (size_t)MP * DM * 2;
constexpr size_t OS_END = OS_KVT + (size_t)32 * GCH * 8192 * 2;
static_assert(OS_END <= (size_t)NBATCH * SEQ * DM * 4, "d_out scratch overflow");
static_assert(WS_END <= (size_t)512 * 1024 * 1024, "workspace overflow");

constexpr int LDS_BYTES = 131072 + 16;

struct Params {
    const float *x, *meta, *norm1, *w_in, *lam_re, *lam_im, *log_step, *b_re, *b_im, *c_re, *c_im, *d_skip, *w_glu, *b_glu, *w_pa, *w_alpha, *b_alpha,
        *gla_norm, *w_pb, *w_out, *norm2, *w_ff1, *w_ff3, *w_ff2, *norm_f;
    float* out; unsigned char* ws; int ph_lo, ph_hi, bid, nblk, dry, pad_;
};

__device__ __forceinline__ float bf2f(bf16_t b) { return __uint_as_float(((unsigned)b) << 16); }
__device__ __forceinline__ float bflo(unsigned w) { return __uint_as_float(w << 16); }
__device__ __forceinline__ float bfhi(unsigned w) { return __uint_as_float(w & 0xffff0000u); }
typedef __bf16 bf16n2 __attribute__((ext_vector_type(2)));
__device__ __forceinline__ unsigned cvt_pk_bf16(float lo, float hi) { const f32x2 f = {lo, hi}; const bf16n2 v = __builtin_convertvector(f, bf16n2); return __builtin_bit_cast(unsigned, v); }
__device__ __forceinline__ bf16_t f2bf(float f) { return (bf16_t)(cvt_pk_bf16(f, 0.f) & 0xffffu); }
__device__ __forceinline__ float sigmoidf_(float x) { return __builtin_amdgcn_rcpf(1.0f + __expf(-x)); }
__device__ __forceinline__ float siluf_(float x) { return x * sigmoidf_(x); }
__device__ __forceinline__ float logsigmoidf_(float x) { return fminf(x, 0.f) - __logf(1.0f + __expf(-fabsf(x))); }
__device__ __forceinline__ float gelu_tanh(float x) { const float u = 0.7978845608f * (x + 0.044715f * x * x * x); return x * sigmoidf_(2.f * u); }
__device__ __forceinline__ f32x4 mfma16(bf16x8 colfrag, bf16x8 rowfrag, f32x4 acc) { return __builtin_amdgcn_mfma_f32_16x16x32_bf16(colfrag, rowfrag, acc, 0, 0, 0); }
__device__ __forceinline__ int otid() { int t = threadIdx.x; asm volatile("" : "+v"(t)); return t; }
__device__ __forceinline__ float shx(float v, int lane, int o) { return __int_as_float(__builtin_amdgcn_ds_bpermute((lane ^ o) << 2, __float_as_int(v))); }

struct RsPre { float rs[2][4]; };
namespace pg8 {
constexpr int BM = 256, BK = 64, HALF = 128, HTB = HALF * BK * 2, STAGE_BYTES = 8 * HTB, NXCD = 8, WGM = 8;
__host__ __device__ __forceinline__ int lds_byte(int r, int c) { const int st = (r >> 4) * 2 + (c >> 5), rr = r & 15, cc = c & 31, ob = rr * 64 + cc * 2; return st * 1024 + (ob ^ (((ob >> 9) & 1) << 5)); }
__host__ __device__ __forceinline__ void stage_rc(int b, int& R, int& C) { const int st = b / 1024, sb = b % 1024, swz = sb ^ (((sb >> 9) & 1) << 5); R = (st >> 1) * 16 + swz / 64; C = (st & 1) * 32 + (swz % 64) / 2; }
__host__ __device__ __forceinline__ int perm32(int rho) { const int n = rho >> 4, i = rho & 15; return 8 * (i >> 2) + 4 * n + (i & 3); }
struct Unit { int pm, pn, k0, nt, split, alt; };
struct Gemm { const bf16_t* A; const bf16_t* Bt; int M, N, K, lda; const bf16_t* A2; const bf16_t* Bt2; };
struct StaticOrder {
    int nM, nN, nwg, G, c, ntK, nsplit, pairs;
    __device__ void init(int M, int N, int K, int G_, int c_, int nsplit_ = 0, int pairs_ = 0) { pairs = pairs_; nM = M / BM - (nsplit_ > 0 ? 1 : 0); nN = N / BM; nwg = nM * nN; G = G_; c = c_; ntK = K / BK; nsplit = nsplit_; }
    __device__ bool next(int i, Unit& u) const {
        const long L = (long)(pairs ? (i >> 1) : i) * G + c; u.alt = pairs ? (i & 1) : 0;
        if (L >= (long)nwg + nsplit * nN) return false;
        const bool tail = L >= nwg; const int j = tail ? (int)(L - nwg) : 0, ns = nsplit > 0 ? nsplit : 1;
        int wgid = tail ? 0 : (int)L; { const int q = nwg / NXCD, r = nwg % NXCD, xcd = wgid % NXCD, off = wgid / NXCD; wgid = (xcd < r ? xcd * (q + 1) : r * (q + 1) + (xcd - r) * q) + off; }
        const int nig = WGM * nN, gid = wgid / nig, fm = gid * WGM, gsz = (nM - fm) < WGM ? (nM - fm) : WGM;
        const int pmf = fm + ((wgid % nig) % gsz), pnf = (wgid % nig) / gsz, ntt = ntK / ns;
        u.pm = tail ? nM : pmf; u.pn = tail ? j % nN : pnf; u.nt = tail ? ntt : ntK; u.k0 = tail ? (j / nN) * ntt * BK : 0; u.split = tail ? (j / nN) + 1 : 0; return true;
    }
};

template <class Epi>
__device__ __forceinline__ void gemm_phase(LAS unsigned char* lds, const Gemm g, const StaticOrder& S, const Epi& E) {
    const int tid = otid();
    const int wid = __builtin_amdgcn_readfirstlane(tid >> 6), lane = tid & 63, wr = wid >> 2, wc = wid & 3, fr = lane & 15, fq = lane >> 4;
    const int K = g.K, lda = g.lda;
    unsigned voffA[2], voffB[2];
#pragma unroll
    for (int i = 0; i < 2; ++i) { int R, C; stage_rc(tid * 16 + i * 8192, R, C); const int Rb = Epi::PERM ? ((R & ~31) + perm32(R & 31)) : R;
        voffA[i] = (unsigned)(R * lda + C) * 2u; voffB[i] = (unsigned)(Rb * K + C) * 2u; }
    const size_t kstep = (size_t)(BK * 2);
    const size_t hA = (size_t)HALF * lda * 2, hB = (size_t)HALF * K * 2;
    const size_t tA = 2 * hA, tB = 2 * hB;
    const unsigned ldsw = (unsigned)wid * 1024u;
    const int aoff = lds_byte(wr * 64 + fr, fq * 8), boff = lds_byte(wc * 32 + fr, fq * 8);
#define PG8_SA(b, h) (((b) * 2 + (h)) * HTB)
#define PG8_SB(b, h) ((4 + (b) * 2 + (h)) * HTB)
#define PG8_STAGE(bufoff, gbase, voff) do { _Pragma("unroll") for (int _i = 0; _i < 2; ++_i) \
        __builtin_amdgcn_global_load_lds((const unsigned*)((const char*)(gbase) + (voff)[_i]), (LAS unsigned*)(lds + (bufoff) + ldsw + _i * 8192), 16, 0, 0); } while (0)
#define PG8_LDA(dst, b, h) do { _Pragma("unroll") for (int m = 0; m < 4; ++m) _Pragma("unroll") for (int k = 0; k < 2; ++k) dst[m][k] = *(const LAS bf16x8*)(lds + PG8_SA(b, h) + aoff + m * 2048 + k * 1024); } while (0)
#define PG8_LDB(dst, b, h) do { _Pragma("unroll") for (int n = 0; n < 2; ++n) _Pragma("unroll") for (int k = 0; k < 2; ++k) dst[n][k] = *(const LAS bf16x8*)(lds + PG8_SB(b, h) + boff + n * 2048 + k * 1024); } while (0)
#define PG8_MMA(ai, bj, At, Bt) do { __builtin_amdgcn_s_setprio(1); _Pragma("unroll") for (int m = 0; m < 4; ++m) _Pragma("unroll") for (int n = 0; n < 2; ++n) _Pragma("unroll") for (int k = 0; k < 2; ++k) \
        acc[ai][bj][m][n] = __builtin_amdgcn_mfma_f32_16x16x32_bf16(Bt[n][k], At[m][k], acc[ai][bj][m][n], 0, 0, 0); __builtin_amdgcn_s_setprio(0); } while (0)
#define PG8_WAIT_V(n) asm volatile("s_waitcnt vmcnt(" #n ")" ::: "memory")
#define PG8_WAIT_L(n) asm volatile("s_waitcnt lgkmcnt(" #n ")" ::: "memory")
#define PG8_BAR __builtin_amdgcn_s_barrier()
#define PG8_SCHED __builtin_amdgcn_sched_barrier(0)
    Unit cur, nxt; int ui = 0;
    if (!S.next(0, cur)) return;
    f32x4 acc[2][2][4][2];
#pragma unroll
    for (int a = 0; a < 2; ++a)
#pragma unroll
        for (int b = 0; b < 2; ++b)
#pragma unroll
            for (int m = 0; m < 4; ++m)
#pragma unroll
                for (int n = 0; n < 2; ++n) acc[a][b][m][n] = (f32x4){0.f, 0.f, 0.f, 0.f};
    bf16x8 At[4][2], B0[2][2], B1[2][2];
    RsPre pre;
    if constexpr (Epi::HAS_PRE) E.pre(pre, cur, wr, fr);
    const char* cA = (const char*)(cur.alt ? g.A2 : g.A) + (size_t)cur.pm * tA + (size_t)cur.k0 * 2; const char* cB = (const char*)(cur.alt ? g.Bt2 : g.Bt) + (size_t)cur.pn * tB + (size_t)cur.k0 * 2;
    PG8_STAGE(PG8_SB(0, 0), cB, voffB); PG8_STAGE(PG8_SA(0, 0), cA, voffA); PG8_STAGE(PG8_SB(0, 1), cB + hB, voffB); PG8_STAGE(PG8_SA(0, 1), cA + hA, voffA);
    if (wr == 1) PG8_BAR;
    PG8_WAIT_V(4); PG8_BAR;
    PG8_STAGE(PG8_SB(1, 0), cB + kstep, voffB); PG8_STAGE(PG8_SA(1, 0), cA + kstep, voffA); PG8_STAGE(PG8_SB(1, 1), cB + hB + kstep, voffB);
    PG8_WAIT_V(6); PG8_BAR;
    for (;;) {
        const bool has_next = S.next(ui + 1, nxt);
        const char* nA = has_next ? (const char*)(nxt.alt ? g.A2 : g.A) + (size_t)nxt.pm * tA + (size_t)nxt.k0 * 2 : cA; const char* nB = has_next ? (const char*)(nxt.alt ? g.Bt2 : g.Bt) + (size_t)nxt.pn * tB + (size_t)nxt.k0 * 2 : cB;
        const int nt = cur.nt;
        for (int t = 0; t < nt; t += 2) {
            const bool last = (t == nt - 2);
            const char* a1 = cA + (size_t)(t + 1) * kstep;
            const char* a2 = last ? nA : cA + (size_t)(t + 2) * kstep; const char* b2 = last ? nB : cB + (size_t)(t + 2) * kstep;
            const char* a3 = a2 + kstep; const char* b3 = b2 + kstep;
            PG8_LDB(B0, 0, 0); PG8_SCHED; PG8_LDA(At, 0, 0); PG8_STAGE(PG8_SA(1, 1), a1 + hA, voffA);
            PG8_WAIT_L(8); PG8_BAR; PG8_WAIT_L(0); PG8_MMA(0, 0, At, B0); PG8_BAR; PG8_SCHED;
            PG8_LDB(B1, 0, 1); PG8_STAGE(PG8_SB(0, 0), b2, voffB);
            PG8_BAR; PG8_WAIT_L(0); PG8_MMA(0, 1, At, B1); PG8_BAR;
            PG8_LDA(At, 0, 1); PG8_STAGE(PG8_SA(0, 0), a2, voffA);
            PG8_BAR; PG8_WAIT_L(0); PG8_MMA(1, 0, At, B0); PG8_BAR; PG8_SCHED;
            PG8_STAGE(PG8_SB(0, 1), b2 + hB, voffB);
            PG8_WAIT_V(6); PG8_BAR; PG8_MMA(1, 1, At, B1); PG8_BAR;
            PG8_LDB(B0, 1, 0); PG8_SCHED; PG8_LDA(At, 1, 0); PG8_STAGE(PG8_SA(0, 1), a2 + hA, voffA);
            PG8_WAIT_L(8); PG8_BAR; PG8_WAIT_L(0); PG8_MMA(0, 0, At, B0); PG8_BAR; PG8_SCHED;
            PG8_LDB(B1, 1, 1); PG8_STAGE(PG8_SB(1, 0), b3, voffB);
            PG8_BAR; PG8_WAIT_L(0); PG8_MMA(0, 1, At, B1); PG8_BAR;
            PG8_LDA(At, 1, 1); PG8_STAGE(PG8_SA(1, 0), a3, voffA);
            PG8_BAR; PG8_WAIT_L(0); PG8_MMA(1, 0, At, B0); PG8_BAR; PG8_SCHED;
            PG8_STAGE(PG8_SB(1, 1), b3 + hB, voffB);
            PG8_WAIT_V(6); PG8_BAR; PG8_MMA(1, 1, At, B1); PG8_BAR;
        }
        if constexpr (Epi::HAS_PRE) { E(acc, cur, wr, wc, fr, fq, pre); if (has_next) E.pre(pre, nxt, wr, fr); } else E(acc, cur, wr, wc, fr, fq);
        if (!has_next) break;
        if (!(Epi::PAIRS && cur.alt == 0)) {
#pragma unroll
        for (int a = 0; a < 2; ++a)
#pragma unroll
            for (int b = 0; b < 2; ++b)
#pragma unroll
                for (int m = 0; m < 4; ++m)
#pragma unroll
                    for (int n = 0; n < 2; ++n) acc[a][b][m][n] = (f32x4){0.f, 0.f, 0.f, 0.f}; }
        cur = nxt; cA = nA; cB = nB; ++ui;
    }
    PG8_WAIT_V(0);
    if (wr == 0) PG8_BAR;
    PG8_BAR;
#undef PG8_SA
#undef PG8_SB
#undef PG8_STAGE
#undef PG8_LDA
#undef PG8_LDB
#undef PG8_MMA
#undef PG8_WAIT_V
#undef PG8_WAIT_L
#undef PG8_BAR
#undef PG8_SCHED
}
}
using pg8::Unit;
typedef f32x4 Acc[2][2][4][2];

__device__ __forceinline__ u32x4 pack8(const f32x4 a, const f32x4 b) { u32x4 w; w.x = cvt_pk_bf16(a[0], a[1]); w.y = cvt_pk_bf16(a[2], a[3]); w.z = cvt_pk_bf16(b[0], b[1]); w.w = cvt_pk_bf16(b[2], b[3]); return w; }
__device__ __forceinline__ void unpack8(const u32x4 w, f32x4& a, f32x4& b) { a = (f32x4){bflo(w.x), bfhi(w.x), bflo(w.y), bfhi(w.y)}; b = (f32x4){bflo(w.z), bfhi(w.z), bflo(w.w), bfhi(w.w)}; }
__device__ __forceinline__ f32x4 sig4(const f32x4 v) { return (f32x4){sigmoidf_(v[0]), sigmoidf_(v[1]), sigmoidf_(v[2]), sigmoidf_(v[3])}; }

__device__ __forceinline__ float row_rs(const float* ssq, int row) {
    const f32x4* q = (const f32x4*)(ssq + (size_t)row * 16); const f32x4 a = q[0], b = q[1], c = q[2], d = q[3];
    const float s = ((a[0] + a[1]) + (a[2] + a[3])) + ((b[0] + b[1]) + (b[2] + b[3])) + ((c[0] + c[1]) + (c[2] + c[3])) + ((d[0] + d[1]) + (d[2] + d[3]));
    return rsqrtf(s * (1.0f / DM) + EPS);
}
struct EpiStore {
    static constexpr bool PERM = true, HAS_PRE = true, PAIRS = false;
    bf16_t* O; int ldc; const float* rsv;
    __device__ __forceinline__ void pre(RsPre& r, const Unit& u, int wr, int fr) const {
#pragma unroll
        for (int ai = 0; ai < 2; ++ai)
#pragma unroll
            for (int m = 0; m < 4; ++m) r.rs[ai][m] = rsv[u.pm * 256 + wr * 64 + fr + ai * 128 + m * 16]; }
    __device__ __forceinline__ void operator()(const Acc& acc, const Unit& u, int wr, int wc, int fr, int fq, const RsPre& pr) const {
        asm volatile("" : "+v"(fr), "+v"(fq));
        const int row0 = u.pm * 256 + wr * 64 + fr, col0 = u.pn * 256 + wc * 32 + 8 * fq;
        const float (&rs)[2][4] = pr.rs;
#pragma unroll
        for (int ai = 0; ai < 2; ++ai)
#pragma unroll
            for (int m = 0; m < 4; ++m) { bf16_t* rowp = O + (size_t)(row0 + ai * 128 + m * 16) * ldc + col0;
#pragma unroll
                for (int bj = 0; bj < 2; ++bj) *(u32x4*)(rowp + bj * 128) = pack8(acc[ai][bj][m][0] * rs[ai][m], acc[ai][bj][m][1] * rs[ai][m]); }
    }
};
struct EpiGlu {
    static constexpr bool PERM = true, HAS_PRE = false, PAIRS = false;
    bf16_t* proj; const float* bias;
    __device__ __forceinline__ void operator()(const Acc& acc, const Unit& u, int wr, int wc, int fr, int fq) const {
        asm volatile("" : "+v"(fr), "+v"(fq));
        const int row0 = u.pm * 256 + wr * 64 + fr, col0 = u.pn * 256 + wc * 32 + 8 * fq;
        f32x4 bv[2][2];
#pragma unroll
        for (int bj = 0; bj < 2; ++bj)
#pragma unroll
            for (int n = 0; n < 2; ++n) bv[bj][n] = *(const f32x4*)(bias + col0 + bj * 128 + 4 * n);
#pragma unroll
        for (int ai = 0; ai < 2; ++ai) {
            u32x4 av[4][2];
#pragma unroll
            for (int m = 0; m < 4; ++m)
#pragma unroll
                for (int bj = 0; bj < 2; ++bj) av[m][bj] = *(const u32x4*)(proj + (size_t)(row0 + ai * 128 + m * 16) * NPROJ + col0 + bj * 128);
#pragma unroll
            for (int m = 0; m < 4; ++m) { bf16_t* rowp = proj + (size_t)(row0 + ai * 128 + m * 16) * NPROJ + col0;
#pragma unroll
                for (int bj = 0; bj < 2; ++bj) { f32x4 a0, a1; unpack8(av[m][bj], a0, a1);
                    const f32x4 o0 = a0 * sig4(acc[ai][bj][m][0] + bv[bj][0]), o1 = a1 * sig4(acc[ai][bj][m][1] + bv[bj][1]);
                    *(u32x4*)(rowp + C_GLU + bj * 128) = pack8(o0, o1); } } }
    }
};
template <int SECOND> struct EpiMix {
    static constexpr bool PERM = true, HAS_PRE = false, PAIRS = false;
    const bf16_t* gate; bf16_t* mixed;
    __device__ __forceinline__ void operator()(const Acc& acc, const Unit& u, int wr, int wc, int fr, int fq) const {
        asm volatile("" : "+v"(fr), "+v"(fq));
        const int row0 = u.pm * 256 + wr * 64 + fr, col0 = u.pn * 256 + wc * 32 + 8 * fq;
#pragma unroll
        for (int ai = 0; ai < 2; ++ai) {
            u32x4 gv[4][2], pv[4][2];
#pragma unroll
            for (int m = 0; m < 4; ++m)
#pragma unroll
                for (int bj = 0; bj < 2; ++bj) { const size_t row = (size_t)(row0 + ai * 128 + m * 16);
                    gv[m][bj] = *(const u32x4*)(gate + row * NPROJ + col0 + bj * 128);
                    if (SECOND) pv[m][bj] = *(const u32x4*)(mixed + row * 1024 + col0 + bj * 128); }
#pragma unroll
            for (int m = 0; m < 4; ++m) { const size_t row = (size_t)(row0 + ai * 128 + m * 16);
#pragma unroll
                for (int bj = 0; bj < 2; ++bj) { f32x4 g0, g1; unpack8(gv[m][bj], g0, g1);
                    f32x4 o0 = acc[ai][bj][m][0] * sig4(g0), o1 = acc[ai][bj][m][1] * sig4(g1);
                    if (SECOND) { f32x4 p0, p1; unpack8(pv[m][bj], p0, p1); o0 += p0; o1 += p1; }
                    *(u32x4*)(mixed + row * 1024 + col0 + bj * 128) = pack8(o0, o1); } } }
    }
};
struct EpiMixPair {
    static constexpr bool PERM = true, HAS_PRE = false, PAIRS = true;
    const bf16_t* ga; const bf16_t* gb; bf16_t* mixed;
    __device__ __forceinline__ void operator()(Acc& acc, const Unit& u, int wr, int wc, int fr, int fq) const {
        asm volatile("" : "+v"(fr), "+v"(fq));
        const int row0 = u.pm * 256 + wr * 64 + fr, col0 = u.pn * 256 + wc * 32 + 8 * fq;
#pragma unroll
        for (int ai = 0; ai < 2; ++ai) {
            u32x4 av[4][2], bv[4][2];
#pragma unroll
            for (int m = 0; m < 4; ++m)
#pragma unroll
                for (int bj = 0; bj < 2; ++bj) { const size_t off = (size_t)(row0 + ai * 128 + m * 16) * NPROJ + col0 + bj * 128;
                    bv[m][bj] = *(const u32x4*)(gb + off); if (u.alt == 0) av[m][bj] = *(const u32x4*)(ga + off); }
#pragma unroll
            for (int m = 0; m < 4; ++m)
#pragma unroll
                for (int bj = 0; bj < 2; ++bj) { f32x4 b0, b1; unpack8(bv[m][bj], b0, b1);
                    if (u.alt == 0) { f32x4 a0, a1; unpack8(av[m][bj], a0, a1);
#pragma unroll
                        for (int r = 0; r < 4; ++r) { acc[ai][bj][m][0][r] *= (1.0f + __expf(-b0[r])) * __builtin_amdgcn_rcpf(1.0f + __expf(-a0[r]));
                                                      acc[ai][bj][m][1][r] *= (1.0f + __expf(-b1[r])) * __builtin_amdgcn_rcpf(1.0f + __expf(-a1[r])); } }
                    else *(u32x4*)(mixed + (size_t)(row0 + ai * 128 + m * 16) * 1024 + col0 + bj * 128) = pack8(acc[ai][bj][m][0] * sig4(b0), acc[ai][bj][m][1] * sig4(b1)); } }
    }
};
struct EpiRes {
    static constexpr bool PERM = true, HAS_PRE = false, PAIRS = false;
    bf16_t* hb; float sc; float* part; float* ssq;
    __device__ __forceinline__ void operator()(const Acc& acc, const Unit& u, int wr, int wc, int fr, int fq) const {
        asm volatile("" : "+v"(fr), "+v"(fq));
        const int row0 = u.pm * 256 + wr * 64 + fr, col0 = u.pn * 256 + wc * 32 + 8 * fq;
        if (u.split) {
            float* pt = part + (size_t)(u.split - 1) * 256 * DM;
#pragma unroll
            for (int ai = 0; ai < 2; ++ai)
#pragma unroll
                for (int m = 0; m < 4; ++m)
#pragma unroll
                    for (int bj = 0; bj < 2; ++bj)
#pragma unroll
                        for (int n = 0; n < 2; ++n) *(f32x4*)(pt + (size_t)(wr * 64 + fr + ai * 128 + m * 16) * DM + col0 + bj * 128 + n * 4) = acc[ai][bj][m][n] * sc;
            return; }
#pragma unroll
        for (int ai = 0; ai < 2; ++ai) {
            u32x4 hv[4][2];
#pragma unroll
            for (int m = 0; m < 4; ++m)
#pragma unroll
                for (int bj = 0; bj < 2; ++bj) hv[m][bj] = *(const u32x4*)(hb + (size_t)(row0 + ai * 128 + m * 16) * DM + col0 + bj * 128);
#pragma unroll
            for (int m = 0; m < 4; ++m) { const size_t row = (size_t)(row0 + ai * 128 + m * 16); float sq = 0.f;
#pragma unroll
                for (int bj = 0; bj < 2; ++bj) { f32x4 o0, o1; unpack8(hv[m][bj], o0, o1); o0 += acc[ai][bj][m][0] * sc; o1 += acc[ai][bj][m][1] * sc;
                    *(u32x4*)(hb + row * DM + col0 + bj * 128) = pack8(o0, o1);
                    sq += ((o0[0] * o0[0] + o0[1] * o0[1]) + (o0[2] * o0[2] + o0[3] * o0[3])) + ((o1[0] * o1[0] + o1[1] * o1[1]) + (o1[2] * o1[2] + o1[3] * o1[3])); }
                const int lane = fq * 16 + fr; sq += shx(sq, lane, 16); sq += shx(sq, lane, 32);
                if (fq == 0) ssq[row * 16 + u.pn * 4 + wc] = sq; } }
    }
};
struct EpiFF {
    static constexpr bool PERM = true, HAS_PRE = true, PAIRS = false;
    bf16_t* ff; const float* rsv;
    __device__ __forceinline__ void pre(RsPre& r, const Unit& u, int wr, int fr) const {
#pragma unroll
        for (int ai = 0; ai < 2; ++ai)
#pragma unroll
            for (int m = 0; m < 4; ++m) r.rs[ai][m] = rsv[u.pm * 256 + wr * 64 + fr + ai * 128 + m * 16]; }
    __device__ __forceinline__ void operator()(const Acc& acc, const Unit& u, int wr, int wc, int fr, int fq, const RsPre& pr) const {
        asm volatile("" : "+v"(fr), "+v"(fq));
        const int row0 = u.pm * 256 + wr * 64 + fr, col0 = u.pn * 128 + wc * 32 + 8 * fq;
        const float (&rs)[2][4] = pr.rs;
#pragma unroll
        for (int ai = 0; ai < 2; ++ai)
#pragma unroll
            for (int m = 0; m < 4; ++m) { f32x4 o[2];
#pragma unroll
                for (int n = 0; n < 2; ++n) { const f32x4 a1 = acc[ai][0][m][n] * rs[ai][m], a3 = acc[ai][1][m][n] * rs[ai][m];
                    o[n] = (f32x4){siluf_(a1[0]) * a3[0], siluf_(a1[1]) * a3[1], siluf_(a1[2]) * a3[2], siluf_(a1[3]) * a3[3]}; }
                *(u32x4*)(ff + (size_t)(row0 + ai * 128 + m * 16) * DFF + col0) = pack8(o[0], o[1]); }
    }
};

__device__ __forceinline__ void conv_tile(const float* src, int ldsrc, int scol0, int k0, bf16_t* dst, int drow0, int K, float* lds, const float* ks = nullptr) {
    const int t = otid();
#pragma unroll
    for (int i = 0; i < 2; ++i) { const int r = (t >> 4) + 32 * i, c4 = (t & 15) * 4;
        const f32x4 v = *(const f32x4*)(src + (size_t)(k0 + r) * ldsrc + scol0 + c4);
        lds[r * 65 + c4 + 0] = v[0]; lds[r * 65 + c4 + 1] = v[1]; lds[r * 65 + c4 + 2] = v[2]; lds[r * 65 + c4 + 3] = v[3]; }
    __syncthreads();
    { const int n = t >> 3, kc = (t & 7) * 8; float v[8];
#pragma unroll
      for (int j = 0; j < 8; ++j) v[j] = lds[(kc + j) * 65 + n];
      if (ks) {
#pragma unroll
          for (int j = 0; j < 8; ++j) v[j] *= ks[k0 + kc + j]; }
      u32x4 w; w.x = cvt_pk_bf16(v[0], v[1]); w.y = cvt_pk_bf16(v[2], v[3]); w.z = cvt_pk_bf16(v[4], v[5]); w.w = cvt_pk_bf16(v[6], v[7]);
      *(u32x4*)(dst + (size_t)(drow0 + n) * K + k0 + kc) = w; }
    __syncthreads();
}
struct Sub4 { int scol[4], drow[4]; };
__device__ __forceinline__ void conv_tile4(const float* src, int ldsrc, const Sub4& sb, int k0, bf16_t* dst, int K, float* lds, const float* ks) {
    const int t = otid(); f32x4 v[4][2];
#pragma unroll
    for (int j = 0; j < 4; ++j)
#pragma unroll
        for (int i = 0; i < 2; ++i) v[j][i] = *(const f32x4*)(src + (size_t)(k0 + (t >> 4) + 32 * i) * ldsrc + sb.scol[j] + (t & 15) * 4);
    __syncthreads();
#pragma unroll
    for (int j = 0; j < 4; ++j)
#pragma unroll
        for (int i = 0; i < 2; ++i) { float* q = lds + j * 4160 + ((t >> 4) + 32 * i) * 65 + (t & 15) * 4; q[0] = v[j][i][0]; q[1] = v[j][i][1]; q[2] = v[j][i][2]; q[3] = v[j][i][3]; }
    __syncthreads();
    const int n = t >> 3, kc = (t & 7) * 8; float sc[8];
#pragma unroll
    for (int e = 0; e < 8; ++e) sc[e] = ks ? ks[k0 + kc + e] : 1.0f;
#pragma unroll
    for (int j = 0; j < 4; ++j) { float x[8];
#pragma unroll
        for (int e = 0; e < 8; ++e) x[e] = lds[j * 4160 + (kc + e) * 65 + n] * sc[e];
        u32x4 w; w.x = cvt_pk_bf16(x[0], x[1]); w.y = cvt_pk_bf16(x[2], x[3]); w.z = cvt_pk_bf16(x[4], x[5]); w.w = cvt_pk_bf16(x[6], x[7]);
        *(u32x4*)(dst + (size_t)(sb.drow[j] + n) * K + k0 + kc) = w; }
}
constexpr int NCONV_MIX = 256 + 64 + 16 + 32 + 32 + 64;
__device__ void conv_mixer_item(const Params& p, int l, int it, float* lds) {
    bf16_t* W = (bf16_t*)(p.ws + WS_W); Sub4 sb;
    if (it < 256) { const int kt = it & 15, nb = it >> 4;
#pragma unroll
        for (int j = 0; j < 4; ++j) { const int mycol = (nb < 8 ? nb * 256 : 2304 + (nb - 8) * 256) + j * 64; sb.drow[j] = mycol; sb.scol[j] = nb < 8 ? mycol : mycol - 240; }
        conv_tile4(p.w_in + (size_t)l * 1024 * 4112, 4112, sb, kt * 64, W + W_IN, 1024, lds, p.norm1 + (size_t)l * DM); return; }
    it -= 256;
    if (it < 64) {
        const int kb = it & 1, jb = it >> 1, k = kb * 512 + otid();
        const float* src = p.w_in + (size_t)l * 1024 * 4112 + (size_t)k * 4112 + 2048; float a[16];
#pragma unroll
        for (int q = 0; q < 4; ++q) { const f32x4 v = *(const f32x4*)(src + 4 * q); a[4 * q] = v[0]; a[4 * q + 1] = v[1]; a[4 * q + 2] = v[2]; a[4 * q + 3] = v[3]; }
        const float* wa = p.w_alpha + (size_t)l * 16 * 256; const float g1 = p.norm1[(size_t)l * DM + k];
        for (int jj = 0; jj < 8; ++jj) { const int j = jb * 8 + jj; float s = 0.f;
#pragma unroll
            for (int r = 0; r < 16; ++r) s += a[r] * wa[r * 256 + j];
            W[W_IN + (size_t)(C_GL + j) * 1024 + k] = f2bf(s * g1); }
        return; }
    it -= 64;
    const float* src; int ld, kt, nb, K; size_t wo;
    if (it < 16) { src = p.w_glu + (size_t)l * 512 * 512; ld = 512; kt = it & 7; nb = it >> 3; K = 512; wo = W_GLU; }
    else if ((it -= 16) < 32) { src = p.w_pa + (size_t)l * 512 * 1024; ld = 1024; kt = it & 7; nb = it >> 3; K = 512; wo = W_PA; }
    else if ((it -= 32) < 32) { src = p.w_pb + (size_t)l * 512 * 1024; ld = 1024; kt = it & 7; nb = it >> 3; K = 512; wo = W_PB; }
    else { it -= 32; src = p.w_out + (size_t)l * 1024 * 1024; ld = 1024; kt = it & 15; nb = it >> 4; K = 1024; wo = W_OUT; }
#pragma unroll
    for (int j = 0; j < 4; ++j) { sb.scol[j] = nb * 256 + j * 64; sb.drow[j] = nb * 256 + j * 64; }
    conv_tile4(src, ld, sb, kt * 64, W + wo, K, lds, nullptr);
}
constexpr int NCONV_FF = 3 * 176;
__device__ void conv_ff_item(const Params& p, int l, int it, float* lds) {
    bf16_t* W = (bf16_t*)(p.ws + WS_W); Sub4 sb;
    if (it < 352) { const int which = it >= 176; if (which) it -= 176;
        const int kt = it & 15, nb = it >> 4;
        const float* src = (which ? p.w_ff3 : p.w_ff1) + (size_t)l * 1024 * DFF;
#pragma unroll
        for (int j = 0; j < 4; ++j) { const int n0 = nb * 256 + j * 64; sb.scol[j] = n0; sb.drow[j] = (n0 >> 7) * 256 + (n0 & 127) + which * 128; }
        conv_tile4(src, DFF, sb, kt * 64, W + W_FF13, 1024, lds, p.norm2 + (size_t)l * DM); return; }
    it -= 352;
    { const int nb = it & 3, kt = it >> 2;
#pragma unroll
      for (int j = 0; j < 4; ++j) { sb.scol[j] = nb * 256 + j * 64; sb.drow[j] = nb * 256 + j * 64; }
      conv_tile4(p.w_ff2 + (size_t)l * DFF * 1024, 1024, sb, kt * 64, W + W_FF2, DFF, lds, nullptr); }
}

__device__ __forceinline__ void sincos_small(float x, float& sn, float& cs) {
    const float k = rintf(x * 0.636619772f);
    float r = fmaf(-k, 1.5703125f, x); r = fmaf(-k, 4.837512969970703125e-4f, r); r = fmaf(-k, 7.54978995489188216e-8f, r);
    const int q = ((int)k) & 3; const float r2 = r * r;
    const float sp = r + r * r2 * (-1.6666654611e-1f + r2 * (8.3321608736e-3f + r2 * (-1.9515295891e-4f)));
    const float cp = 1.0f - 0.5f * r2 + r2 * r2 * (4.166664568298827e-2f + r2 * (-1.388731625493765e-3f + r2 * 2.443315711809948e-5f));
    sn = (q == 0) ? sp : (q == 1) ? cp : (q == 2) ? -sp : -cp;
    cs = (q == 0) ? cp : (q == 1) ? -sp : (q == 2) ? -cp : sp;
}
__device__ void s5_prep_item(const Params& p, int l, int gi, float* lds) {
    const int g = gi >> 3, part = gi & 7;
    __syncthreads();
    float* ap_re = lds;
    float* ap_im = ap_re + 17 * 64;
    float* bb_re = ap_im + 17 * 64;
    float* bb_im = bb_re + 1024;
    float* cc_re = bb_im + 1024;
    float* cc_im = cc_re + 1024;
    float* Kd = cc_im + 1024;
    const int t = otid();
    const size_t lg = (size_t)l * 32 + g;
    if (t < 64) { const int pp = t;
        const float step = expf(p.log_step[lg]);
        const float lr = fminf(p.lam_re[lg * 64 + pp], -1e-4f), li = p.lam_im[lg * 64 + pp];
        const float mag = expf(lr * step); float sn, cs; sincos_small(li * step, sn, cs);
        const float abr = mag * cs, abi = mag * sn;
        float pr = 1.f, pi = 0.f;
        for (int d = 0; d <= 16; ++d) { ap_re[d * 64 + pp] = pr; ap_im[d * 64 + pp] = pi; const float nr_ = pr * abr - pi * abi, ni_ = pr * abi + pi * abr; pr = nr_; pi = ni_; }
        const float den = lr * lr + li * li, nr = abr - 1.0f, cr = (nr * lr + abi * li) / den, ci = (abi * lr - nr * li) / den;
        for (int h = 0; h < 16; ++h) { const float br = p.b_re[(lg * 64 + pp) * 16 + h], bi = p.b_im[(lg * 64 + pp) * 16 + h];
            bb_re[pp * 16 + h] = cr * br - ci * bi; bb_im[pp * 16 + h] = cr * bi + ci * br; }
        if (part == 0) { float* a16 = (float*)(p.ws + WS_A16) + (g * 64 + pp) * 2; a16[0] = ap_re[16 * 64 + pp]; a16[1] = ap_im[16 * 64 + pp]; }
    }
    for (int i = t; i < 1024; i += 512) { cc_re[i] = p.c_re[lg * 1024 + i]; cc_im[i] = p.c_im[lg * 1024 + i]; }
    __syncthreads();
    for (int i3 = t; i3 < 768; i3 += 512) { const int d = 2 * part - 1 + (i3 >> 8); if (d < 0) continue;
        const int idx = (d << 8) + (i3 & 255), h = (idx >> 4) & 15, h2 = idx & 15; float s = 0.f;
        for (int pp = 0; pp < 64; ++pp) { const float cr = cc_re[h * 64 + pp], ci = cc_im[h * 64 + pp], ar = ap_re[d * 64 + pp], ai = ap_im[d * 64 + pp];
            const float gr = cr * ar - ci * ai, gi = cr * ai + ci * ar; s += gr * bb_re[pp * 16 + h2] - gi * bb_im[pp * 16 + h2]; }
        Kd[idx] = s; }
    __syncthreads();
    bf16_t* Wy = (bf16_t*)(p.ws + WS_WY) + (size_t)g * 256 * 384;
    for (int i2 = part * 4096 + t; i2 < (part + 1) * 4096; i2 += 512) { const int n = i2 >> 7, kk = i2 & 127, j = n >> 4, h = n & 15, pp = kk & 63, im = kk >> 6;
        const float cr = cc_re[h * 64 + pp], ci = cc_im[h * 64 + pp], ar = ap_re[(j + 1) * 64 + pp], ai = ap_im[(j + 1) * 64 + pp];
        Wy[(size_t)n * 384 + 256 + kk] = f2bf(im ? -(cr * ai + ci * ar) : (cr * ar - ci * ai)); }
    bf16_t* Tz = (bf16_t*)(p.ws + WS_TZ) + (size_t)g * 16 * 512;
    for (int idx = part * 1024 + t; idx < (part + 1) * 1024; idx += 512) { const int d = idx >> 9, h = (idx >> 5) & 15, kk = idx & 31, sl = kk >> 4, h2 = kk & 15, lag = d - sl;
        Tz[idx] = f2bf(lag >= 0 ? Kd[(lag << 8) + (h << 4) + h2] : 0.f); }
    bf16_t* We = (bf16_t*)(p.ws + WS_WE) + (size_t)g * 128 * 256;
    for (int idx = part * 4096 + t; idx < (part + 1) * 4096; idx += 512) { const int n = idx >> 8, k = idx & 255, pp = n & 63, im = n >> 6, s = k >> 4, h2 = k & 15;
        const float ar = ap_re[(15 - s) * 64 + pp], ai = ap_im[(15 - s) * 64 + pp], br = bb_re[pp * 16 + h2], bi = bb_im[pp * 16 + h2];
        We[idx] = f2bf(im ? (ar * bi + ai * br) : (ar * br - ai * bi)); }
    __syncthreads();
}

__device__ __forceinline__ float wave_sum(float v, int lane) {
#pragma unroll
    for (int o = 32; o >= 1; o >>= 1) v += shx(v, lane, o);
    return v;
}
__device__ void rmsnorm_rows(const Params& p, float* h, const float* gain, bf16_t* z, int nslice) {
    const int t_ = otid(), wave = t_ >> 6, lane = t_ & 63;
    f32x4 gv[4];
#pragma unroll
    for (int i = 0; i < 4; ++i) gv[i] = *(const f32x4*)(gain + lane * 4 + 256 * i);
    for (int row0 = p.bid * 16 + wave * 2; row0 < MP; row0 += p.nblk * 16) {
        f32x4 v[2][4];
#pragma unroll
        for (int rr = 0; rr < 2; ++rr)
#pragma unroll
            for (int i = 0; i < 4; ++i) v[rr][i] = *(const f32x4*)(h + (size_t)(row0 + rr) * DM + lane * 4 + 256 * i);
#pragma unroll
        for (int rr = 0; rr < 2; ++rr) { const int row = row0 + rr; float* hp = h + (size_t)row * DM; float ss = 0.f;
            if (row >= MP - 256 && nslice > 0) {
                const float* pt = (const float*)(p.ws + WS_PART) + (size_t)(row - (MP - 256)) * DM + lane * 4;
                for (int sl = 0; sl < nslice; ++sl)
#pragma unroll
                    for (int i = 0; i < 4; ++i) v[rr][i] += *(const f32x4*)(pt + (size_t)sl * 256 * DM + 256 * i);
#pragma unroll
                for (int i = 0; i < 4; ++i) *(f32x4*)(hp + lane * 4 + 256 * i) = v[rr][i]; }
#pragma unroll
            for (int i = 0; i < 4; ++i) ss += v[rr][i][0] * v[rr][i][0] + v[rr][i][1] * v[rr][i][1] + v[rr][i][2] * v[rr][i][2] + v[rr][i][3] * v[rr][i][3];
            ss = wave_sum(ss, lane); const float rs = rsqrtf(ss * (1.0f / DM) + EPS);
#pragma unroll
            for (int i = 0; i < 4; ++i) { const f32x4 o = v[rr][i] * rs * gv[i]; u32x2 w; w.x = cvt_pk_bf16(o[0], o[1]); w.y = cvt_pk_bf16(o[2], o[3]);
                *(u32x2*)(z + (size_t)row * DM + lane * 4 + 256 * i) = w; } }
    }
}
__device__ void final_norm(const Params& p, const bf16_t* hb, const float* gain, float* out) {
    const int t_ = otid(), wave = t_ >> 6, lane = t_ & 63;
    f32x4 gv[4];
#pragma unroll
    for (int i = 0; i < 4; ++i) gv[i] = *(const f32x4*)(gain + lane * 4 + 256 * i);
    for (int orow = p.bid * 8 + wave; orow < NBATCH * SEQ; orow += p.nblk * 8) {
        const int b = orow >> 12, tt = orow & 4095, row = b * TB + NMETA + tt; const bf16_t* hp = hb + (size_t)row * DM; f32x4 v[4]; float ss = 0.f;
#pragma unroll
        for (int i = 0; i < 4; ++i) { const u32x2 w = *(const u32x2*)(hp + lane * 4 + 256 * i); v[i] = (f32x4){bflo(w.x), bfhi(w.x), bflo(w.y), bfhi(w.y)}; }
        if (row >= MP - 256) { const float* pt = (const float*)(p.ws + WS_PART) + (size_t)(row - (MP - 256)) * DM + lane * 4;
            for (int sl = 0; sl < 11; ++sl)
#pragma unroll
                for (int i = 0; i < 4; ++i) v[i] += *(const f32x4*)(pt + (size_t)sl * 256 * DM + 256 * i); }
#pragma unroll
        for (int i = 0; i < 4; ++i) ss += v[i][0] * v[i][0] + v[i][1] * v[i][1] + v[i][2] * v[i][2] + v[i][3] * v[i][3];
        ss = wave_sum(ss, lane); const float rs = rsqrtf(ss * (1.0f / DM) + EPS);
#pragma unroll
        for (int i = 0; i < 4; ++i) *(f32x4*)(out + (size_t)orow * DM + lane * 4 + 256 * i) = v[i] * rs * gv[i];
    }
}
__device__ void init_h(const Params& p) {
    bf16_t* hb = (bf16_t*)(p.ws + WS_H);
    const int t_ = otid(), wave = t_ >> 6, lane = t_ & 63;
    for (int row = p.bid * 8 + wave; row < MP; row += p.nblk * 8) {
        const int b = row / TB, r = row - b * TB; f32x4 v[4]; float ss = 0.f;
#pragma unroll
        for (int i = 0; i < 4; ++i) { const int c4 = lane * 4 + 256 * i; v[i] = (f32x4){0.f, 0.f, 0.f, 0.f};
            if (r < NMETA) v[i] = *(const f32x4*)(p.meta + (size_t)r * DM + c4);
            else if (r < NMETA + SEQ) v[i] = *(const f32x4*)(p.x + ((size_t)b * SEQ + (r - NMETA)) * DM + c4);
            u32x2 w; w.x = cvt_pk_bf16(v[i][0], v[i][1]); w.y = cvt_pk_bf16(v[i][2], v[i][3]); *(u32x2*)(hb + (size_t)row * DM + c4) = w;
            ss += v[i][0] * v[i][0] + v[i][1] * v[i][1] + v[i][2] * v[i][2] + v[i][3] * v[i][3]; }
        ss = wave_sum(ss, lane);
        if (lane == 0) ((float*)(p.ws + WS_RS1))[row] = rsqrtf(ss * (1.0f / DM) + EPS);
    }
}
__device__ void fold_rows(const Params& p, int nslice, const float* ssq, float* rsv) {
    bf16_t* hb = (bf16_t*)(p.ws + WS_H);
    const int t_ = otid(), wave = t_ >> 6, lane = t_ & 63;
    for (int idx = p.bid * 8 + wave; idx < 256; idx += p.nblk * 8) {
        const int row = MP - 256 + idx; bf16_t* hp = hb + (size_t)row * DM; f32x4 v[4]; float ss = 0.f;
#pragma unroll
        for (int i = 0; i < 4; ++i) { const u32x2 w = *(const u32x2*)(hp + lane * 4 + 256 * i); v[i] = (f32x4){bflo(w.x), bfhi(w.x), bflo(w.y), bfhi(w.y)}; }
        const float* pt = (const float*)(p.ws + WS_PART) + (size_t)idx * DM + lane * 4;
        for (int s0 = 0; s0 < nslice; s0 += 4) {
            f32x4 tq[4][4];
#pragma unroll
            for (int q = 0; q < 4; ++q) { const int sl = s0 + q < nslice ? s0 + q : nslice - 1;
#pragma unroll
                for (int i = 0; i < 4; ++i) tq[q][i] = *(const f32x4*)(pt + (size_t)sl * 256 * DM + 256 * i); }
#pragma unroll
            for (int q = 0; q < 4; ++q) { const float on = s0 + q < nslice ? 1.f : 0.f;
#pragma unroll
                for (int i = 0; i < 4; ++i) v[i] += tq[q][i] * on; } }
#pragma unroll
        for (int i = 0; i < 4; ++i) { u32x2 w; w.x = cvt_pk_bf16(v[i][0], v[i][1]); w.y = cvt_pk_bf16(v[i][2], v[i][3]); *(u32x2*)(hp + lane * 4 + 256 * i) = w;
            ss += v[i][0] * v[i][0] + v[i][1] * v[i][1] + v[i][2] * v[i][2] + v[i][3] * v[i][3]; }
        ss = wave_sum(ss, lane);
        if (lane == 0) rsv[row] = rsqrtf(ss * (1.0f / DM) + EPS);
    }
    for (int row = p.bid * 512 + t_; row < MP - 256; row += p.nblk * 512) rsv[row] = row_rs(ssq, row);
}

constexpr int S5_ITEMS = 512;
__device__ void s5a_item(const Params& p, int item, LAS unsigned char* lds) {
    const int xcd_ = item & 7, slot_ = (item >> 3) & 31, g = xcd_ * 4 + (slot_ & 3), span = (item >> 8) * 8 + (slot_ >> 2), mt0 = span * 8, nmt = span == 15 ? 9 : 8;
    const int t = otid(), wave = t >> 6, lane = t & 63, fr = lane & 15, fq = lane >> 4;
    const bf16_t* proj = (const bf16_t*)(p.ws + WS_PROJ);
    const bf16_t* We = (const bf16_t*)(p.ws + WS_WE) + (size_t)g * 128 * 256;
    float* Xloc = (float*)(p.ws + WS_XLOC);
    u32x4 wf[8];
#pragma unroll
    for (int q = 0; q < 8; ++q) { const int i = t + 512 * q, r = i >> 5, c = i & 31; wf[q] = *(const u32x4*)(We + r * 256 + c * 8); }
    bf16x8 a[8];
    { const int mt = mt0 + wave;
#pragma unroll
      for (int ks = 0; ks < 8; ++ks) a[ks] = *(const bf16x8*)(proj + (size_t)((mt * 16 + fr) * 16 + 2 * ks + (fq >> 1)) * NPROJ + C_U + g * 16 + (fq & 1) * 8); }
    __syncthreads();
#pragma unroll
    for (int q = 0; q < 8; ++q) { const int i = t + 512 * q, r = i >> 5, c = i & 31; *(LAS u32x4*)(lds + r * 528 + c * 16) = wf[q]; }
    __syncthreads();
    for (int mt = mt0 + wave; mt < mt0 + nmt; mt += 8) {
        if (mt != mt0 + wave) {
#pragma unroll
            for (int ks = 0; ks < 8; ++ks) a[ks] = *(const bf16x8*)(proj + (size_t)((mt * 16 + fr) * 16 + 2 * ks + (fq >> 1)) * NPROJ + C_U + g * 16 + (fq & 1) * 8); }
#pragma unroll 1
        for (int nt = 0; nt < 8; ++nt) { f32x4 acc = (f32x4){0.f, 0.f, 0.f, 0.f};
#pragma unroll
            for (int ks = 0; ks < 8; ++ks) { const bf16x8 b = *(const LAS bf16x8*)(lds + (nt * 16 + fr) * 528 + (ks * 32 + fq * 8) * 2); acc = mfma16(b, a[ks], acc); }
            *(f32x4*)(Xloc + ((size_t)(mt * 16 + fr) * 32 + g) * 128 + nt * 16 + 4 * fq) = acc; }
    }
}
__device__ void s5_scan(const Params& p) {
    const int lane = otid() & 63;
    float* Xloc = (float*)(p.ws + WS_XLOC);
    const float* a16 = (const float*)(p.ws + WS_A16);
    for (int ci = p.bid; ci < 256; ci += p.nblk) {
        const int b = ci >> 5, g = ci & 31;
        const float ar = a16[(g * 64 + lane) * 2], ai = a16[(g * 64 + lane) * 2 + 1];
        float* base = Xloc + ((size_t)(b * 258) * 32 + g) * 128 + lane;
        float sr = 0.f, si = 0.f;
        for (int c0 = 0; c0 < 258; c0 += 43) { float xr[43], xi[43];
#pragma unroll
            for (int j = 0; j < 43; ++j) { xr[j] = base[(size_t)(c0 + j) * 4096]; xi[j] = base[(size_t)(c0 + j) * 4096 + 64]; }
#pragma unroll
            for (int j = 0; j < 43; ++j) { if (!p.dry) { base[(size_t)(c0 + j) * 4096] = sr; base[(size_t)(c0 + j) * 4096 + 64] = si; }
                const float nr = ar * sr - ai * si + xr[j], ni = ar * si + ai * sr + xi[j]; sr = nr; si = ni; } }
    }
}
__device__ void s5c_item(const Params& p, int l, int item, LAS unsigned char* lds) {
    const int xcd_ = item & 7, slot_ = (item >> 3) & 31, g = xcd_ * 4 + (slot_ & 3), span = (item >> 8) * 8 + (slot_ >> 2), mt0 = span * 8, nmt = span == 15 ? 9 : 8, iters = (nmt + 7) >> 3;
    const int t = otid(), wave = t >> 6, lane = t & 63, fr = lane & 15, fq = lane >> 4;
    bf16_t* proj = (bf16_t*)(p.ws + WS_PROJ);
    const bf16_t* Wy = (const bf16_t*)(p.ws + WS_WY) + (size_t)g * 256 * 384;
    const bf16_t* Tz = (const bf16_t*)(p.ws + WS_TZ) + (size_t)g * 16 * 512;
    const float* Xin = (const float*)(p.ws + WS_XLOC);
    const f32x4 dsk = *(const f32x4*)(p.d_skip + (size_t)l * 512 + g * 16 + 4 * fq);
    for (int it = 0; it < iters; ++it) {
        const int mt = mt0 + it * 8 + wave; const bool active = mt < mt0 + nmt;
        u32x4 omf[8];
#pragma unroll
        for (int q = 0; q < 8; ++q) { const int i = t + 512 * q, r = i >> 4, c = i & 15; omf[q] = *(const u32x4*)(Wy + (size_t)r * 384 + 256 + c * 8); }
        bf16x8 tf[16];
#pragma unroll
        for (int d = 0; d < 16; ++d) tf[d] = *(const bf16x8*)(Tz + d * 512 + fr * 32 + fq * 8);
        bf16x8 a[12];
        if (active) {
#pragma unroll
            for (int ks = 0; ks < 8; ++ks) a[ks] = *(const bf16x8*)(proj + (size_t)((mt * 16 + fr) * 16 + 2 * ks + (fq >> 1)) * NPROJ + C_U + g * 16 + (fq & 1) * 8);
#pragma unroll
            for (int kk = 0; kk < 4; ++kk) { const float* xp = Xin + ((size_t)(mt * 16 + fr) * 32 + g) * 128 + kk * 32 + fq * 8; const f32x4 x0 = *(const f32x4*)xp, x1 = *(const f32x4*)(xp + 4);
                const u32x4 w = pack8(x0, x1); a[8 + kk] = *(const bf16x8*)&w; }
        } else {
#pragma unroll
            for (int ks = 0; ks < 12; ++ks) a[ks] = (bf16x8){0, 0, 0, 0, 0, 0, 0, 0};
        }
        __syncthreads();
#pragma unroll
        for (int q = 0; q < 8; ++q) { const int i = t + 512 * q, r = i >> 4, c = i & 15; *(LAS u32x4*)(lds + r * 272 + c * 16) = omf[q]; }
        u32x2 uwv[16];
        if (active) {
#pragma unroll
            for (int j = 0; j < 16; ++j) uwv[j] = *(const u32x2*)(proj + (size_t)((mt * 16 + fr) * 16 + j) * NPROJ + C_U + g * 16 + 4 * fq);
        } else {
#pragma unroll
            for (int j = 0; j < 16; ++j) uwv[j] = (u32x2){0u, 0u};
        }
        __syncthreads();
        if (active) {
#pragma unroll
            for (int j = 0; j < 16; ++j) { f32x4 acc = (f32x4){0.f, 0.f, 0.f, 0.f};
#pragma unroll
                for (int ks = 0; ks < 8; ++ks) if (ks <= (j >> 1)) acc = mfma16(tf[j - 2 * ks], a[ks], acc);
#pragma unroll
                for (int kk = 0; kk < 4; ++kk) { const bf16x8 b = *(const LAS bf16x8*)(lds + (j * 16 + fr) * 272 + (kk * 32 + fq * 8) * 2); acc = mfma16(b, a[8 + kk], acc); }
                bf16_t* up = proj + (size_t)((mt * 16 + fr) * 16 + j) * NPROJ + C_U + g * 16 + 4 * fq;
                const u32x2 uw = uwv[j];
                const float y0 = acc[0] + dsk[0] * bflo(uw.x), y1 = acc[1] + dsk[1] * bfhi(uw.x), y2 = acc[2] + dsk[2] * bflo(uw.y), y3 = acc[3] + dsk[3] * bfhi(uw.y);
                u32x2 ow; ow.x = cvt_pk_bf16(gelu_tanh(y0), gelu_tanh(y1)); ow.y = cvt_pk_bf16(gelu_tanh(y2), gelu_tanh(y3));
                if (!p.dry) *(u32x2*)up = ow;
                __builtin_amdgcn_sched_barrier(0); }
        }
    }
}

constexpr int GLA_ITEMS = NBATCH * 4 * (GCH / 2);
constexpr int GL_QD = 0, GL_KI = 9216, GL_P = 18432, GL_VT = 27648, GL_SEG = 46080, GL_HALF = 47104;
struct GlaLoads { unsigned short xl[16], xk[16], xq[16], vv[4][8]; };
__device__ __forceinline__ void gla_issue_loads(GlaLoads& L, const bf16_t* proj, int b, int h, int n, int dk, int seg, int t4, bool want_q) {
#pragma unroll
    for (int i = 0; i < 16; ++i) { const int rb = n * 64 + seg * 16 + i, rc = rb < TB ? rb : TB - 1; const bf16_t* rp = proj + (size_t)(b * TB + rc) * NPROJ + h * 64 + dk;
        L.xl[i] = rp[C_GL]; L.xk[i] = rp[C_K]; if (want_q) L.xq[i] = rp[C_Q]; }
#pragma unroll
    for (int q = 0; q < 4; ++q) { const int task = t4 + 256 * q, dv = task & 127, rg = task >> 7;
#pragma unroll
        for (int j = 0; j < 8; ++j) { const int rb = n * 64 + rg * 8 + j, rc = rb < TB ? rb : TB - 1; L.vv[q][j] = proj[(size_t)(b * TB + rc) * NPROJ + C_V + h * 128 + dv]; } }
}
__device__ __forceinline__ float gla_cumsum(const Params& p, int l, const GlaLoads& L, int h, int n, int dk, int seg, LAS unsigned char* hl, float (&bc)[16]) {
    const float ba = p.b_alpha[(size_t)l * 256 + h * 64 + dk]; float run = 0.f;
#pragma unroll
    for (int i = 0; i < 16; ++i) { const int rb = n * 64 + seg * 16 + i; const float la = rb < TB ? logsigmoidf_(bf2f(L.xl[i]) + ba) * (1.0f / 16.0f) : 0.f;
        run += la; bc[i] = run; }
    LAS float* segs = (LAS float*)(hl + GL_SEG);
    segs[seg * 64 + dk] = run;
    __syncthreads();
    float pre = 0.f, tot = 0.f;
#pragma unroll
    for (int s = 0; s < 4; ++s) { const float v = segs[s * 64 + dk]; tot += v; if (s < seg) pre += v; }
#pragma unroll
    for (int i = 0; i < 16; ++i) bc[i] += pre;
    return tot;
}
__device__ __forceinline__ void gla_store_vT(const GlaLoads& L, int n, int t4, LAS unsigned char* hl) {
#pragma unroll
    for (int q = 0; q < 4; ++q) { const int task = t4 + 256 * q, dv = task & 127, rg = task >> 7; unsigned v[8];
#pragma unroll
        for (int j = 0; j < 8; ++j) { const int rb = n * 64 + rg * 8 + j; v[j] = rb < TB ? (unsigned)L.vv[q][j] : 0u; }
        u32x4 w; w.x = v[0] | (v[1] << 16); w.y = v[2] | (v[3] << 16); w.z = v[4] | (v[5] << 16); w.w = v[6] | (v[7] << 16);
        *(LAS u32x4*)(hl + GL_VT + dv * 144 + rg * 16) = w; }
}
__device__ void gla1_item(const Params& p, int l, int item, LAS unsigned char* lds) {
    const int t = otid(), half = t >> 8, t4 = t & 255, wv = (t >> 6) & 3, lane = t & 63, fr = lane & 15, fq = lane >> 4;
    const int pair = item % (GCH / 2), bh = item / (GCH / 2), b = bh >> 2, h = bh & 3, n = pair * 2 + half;
    const bf16_t* proj = (const bf16_t*)(p.ws + WS_PROJ);
    LAS unsigned char* hl = lds + half * GL_HALF;
    const int dk = t4 & 63, seg = t4 >> 6;
    GlaLoads L; gla_issue_loads(L, proj, b, h, n, dk, seg, t4, false);
    __syncthreads();
    float bc[16];
    const float tot = gla_cumsum(p, l, L, h, n, dk, seg, hl, bc);
    { unsigned w[8];
#pragma unroll
      for (int i = 0; i < 16; i += 2) { const int rb = n * 64 + seg * 16 + i;
          const float k0 = rb < TB ? bf2f(L.xk[i]) * __expf(tot - bc[i]) : 0.f, k1 = rb + 1 < TB ? bf2f(L.xk[i + 1]) * __expf(tot - bc[i + 1]) : 0.f;
          w[i >> 1] = cvt_pk_bf16(k0, k1); }
      *(LAS u32x4*)(hl + GL_KI + dk * 144 + seg * 32) = (u32x4){w[0], w[1], w[2], w[3]};
      *(LAS u32x4*)(hl + GL_KI + dk * 144 + seg * 32 + 16) = (u32x4){w[4], w[5], w[6], w[7]}; }
    gla_store_vT(L, n, t4, hl);
    if (seg == 0) ((float*)(p.ws + WS_DECAY))[((size_t)bh * GCH + n) * 64 + dk] = __expf(tot);
    __syncthreads();
    bf16_t* kvT = (bf16_t*)((unsigned char*)p.out + OS_KVT) + ((size_t)bh * GCH + n) * 8192;
#pragma unroll
    for (int mt = 0; mt < 2; ++mt) { const int dv0 = wv * 32 + mt * 16;
        bf16x8 rf[2];
#pragma unroll
        for (int ks = 0; ks < 2; ++ks) rf[ks] = *(const LAS bf16x8*)(hl + GL_VT + (dv0 + fr) * 144 + (ks * 32 + fq * 8) * 2);
#pragma unroll
        for (int nt = 0; nt < 4; ++nt) { f32x4 acc = (f32x4){0.f, 0.f, 0.f, 0.f};
#pragma unroll
            for (int ks = 0; ks < 2; ++ks) { const bf16x8 cf = *(const LAS bf16x8*)(hl + GL_KI + (nt * 16 + fr) * 144 + (ks * 32 + fq * 8) * 2); acc = mfma16(cf, rf[ks], acc); }
            u32x2 w; w.x = cvt_pk_bf16(acc[0], acc[1]); w.y = cvt_pk_bf16(acc[2], acc[3]);
            *(u32x2*)(kvT + (dv0 + fr) * 64 + nt * 16 + 4 * fq) = w; } }
}
__device__ void gla_scan(const Params& p) {
    const int tt = otid() - 64;
    if (tt < 0 || tt >= 256) return;
    bf16_t* kvT = (bf16_t*)((unsigned char*)p.out + OS_KVT);
    const float* decay = (const float*)(p.ws + WS_DECAY);
    for (int blk = p.bid; blk < 256; blk += p.nblk) {
        const int qi = blk * 256 + tt, bh = qi >> 11, rem = qi & 2047, dv = rem >> 4, dkq = rem & 15;
        bf16_t* kp = kvT + (size_t)bh * GCH * 8192 + dv * 64 + dkq * 4; const float* dp = decay + (size_t)bh * GCH * 64 + dkq * 4;
        f32x4 S = (f32x4){0.f, 0.f, 0.f, 0.f};
        for (int n0 = 0; n0 < 65; n0 += 13) { u32x2 w[13]; f32x4 d[13];
#pragma unroll
            for (int j = 0; j < 13; ++j) { w[j] = *(const u32x2*)(kp + (size_t)(n0 + j) * 8192); d[j] = *(const f32x4*)(dp + (n0 + j) * 64); }
#pragma unroll
            for (int j = 0; j < 13; ++j) { u32x2 o; o.x = cvt_pk_bf16(S[0], S[1]); o.y = cvt_pk_bf16(S[2], S[3]); if (!p.dry) *(u32x2*)(kp + (size_t)(n0 + j) * 8192) = o;
                S = d[j] * S + (f32x4){bflo(w[j].x), bfhi(w[j].x), bflo(w[j].y), bfhi(w[j].y)}; } }
    }
}
__device__ void gla3_item(const Params& p, int l, int item, LAS unsigned char* lds) {
    const int t = otid(), half = t >> 8, t4 = t & 255, wv = (t >> 6) & 3, lane = t & 63, fr = lane & 15, fq = lane >> 4;
    const int pair = item % (GCH / 2), bh = item / (GCH / 2), b = bh >> 2, h = bh & 3, n = pair * 2 + half;
    bf16_t* proj = (bf16_t*)(p.ws + WS_PROJ);
    LAS unsigned char* hl = lds + half * GL_HALF;
    const int dk = t4 & 63, seg = t4 >> 6;
    GlaLoads L; gla_issue_loads(L, proj, b, h, n, dk, seg, t4, true);
    const bf16_t* spT = (const bf16_t*)((const unsigned char*)p.out + OS_KVT) + ((size_t)bh * GCH + n) * 8192;
    bf16x8 spf[8][2];
#pragma unroll
    for (int nt = 0; nt < 8; ++nt)
#pragma unroll
        for (int ks = 0; ks < 2; ++ks) spf[nt][ks] = *(const bf16x8*)(spT + (nt * 16 + fr) * 64 + ks * 32 + fq * 8);
    const int rb = n * 64 + wv * 16 + fr, rbc = rb < TB ? rb : TB - 1;
    bf16_t* rowp = proj + (size_t)(b * TB + rbc) * NPROJ;
    u32x2 rwv[8];
#pragma unroll
    for (int nt = 0; nt < 8; ++nt) rwv[nt] = *(const u32x2*)(rowp + C_R + h * 128 + nt * 16 + 4 * fq);
    __syncthreads();
    float bc[16];
    (void)gla_cumsum(p, l, L, h, n, dk, seg, hl, bc);
#pragma unroll
    for (int i = 0; i < 16; ++i) { const int rbi = n * 64 + seg * 16 + i, row = seg * 16 + i;
        const float qv = rbi < TB ? bf2f(L.xq[i]) * 0.125f * __expf(bc[i]) : 0.f, kv = rbi < TB ? bf2f(L.xk[i]) * __expf(-bc[i]) : 0.f;
        *(LAS bf16_t*)(hl + GL_QD + row * 144 + dk * 2) = f2bf(qv); *(LAS bf16_t*)(hl + GL_KI + row * 144 + dk * 2) = f2bf(kv); }
    gla_store_vT(L, n, t4, hl);
    __syncthreads();
    bf16x8 qf[2];
#pragma unroll
    for (int ks = 0; ks < 2; ++ks) qf[ks] = *(const LAS bf16x8*)(hl + GL_QD + (wv * 16 + fr) * 144 + (ks * 32 + fq * 8) * 2);
#pragma unroll
    for (int st = 0; st < 4; ++st) { f32x4 acc = (f32x4){0.f, 0.f, 0.f, 0.f};
        if (st <= wv) {
#pragma unroll
            for (int ks = 0; ks < 2; ++ks) { const bf16x8 cf = *(const LAS bf16x8*)(hl + GL_KI + (st * 16 + fr) * 144 + (ks * 32 + fq * 8) * 2); acc = mfma16(cf, qf[ks], acc); }
            const int c = wv * 16 + fr, s0 = st * 16 + 4 * fq;
#pragma unroll
            for (int r = 0; r < 4; ++r) if (s0 + r > c) acc[r] = 0.f;
        }
        u32x2 w; w.x = cvt_pk_bf16(acc[0], acc[1]); w.y = cvt_pk_bf16(acc[2], acc[3]);
        *(LAS u32x2*)(hl + GL_P + (wv * 16 + fr) * 144 + (st * 16 + 4 * fq) * 2) = w; }
    __syncthreads();
    bf16x8 pf[2];
#pragma unroll
    for (int ks = 0; ks < 2; ++ks) pf[ks] = *(const LAS bf16x8*)(hl + GL_P + (wv * 16 + fr) * 144 + (ks * 32 + fq * 8) * 2);
    f32x4 o[8]; float ss = 0.f;
#pragma unroll
    for (int nt = 0; nt < 8; ++nt) { f32x4 acc = (f32x4){0.f, 0.f, 0.f, 0.f};
#pragma unroll
        for (int ks = 0; ks < 2; ++ks) { const bf16x8 cf = *(const LAS bf16x8*)(hl + GL_VT + (nt * 16 + fr) * 144 + (ks * 32 + fq * 8) * 2); acc = mfma16(cf, pf[ks], acc); }
#if !MK_NO_INTER
#pragma unroll
        for (int ks = 0; ks < 2; ++ks) acc = mfma16(spf[nt][ks], qf[ks], acc);
#endif
        o[nt] = acc; ss += acc[0] * acc[0] + acc[1] * acc[1] + acc[2] * acc[2] + acc[3] * acc[3]; }
    ss += shx(ss, lane, 16); ss += shx(ss, lane, 32);
    const float rstd = rsqrtf(ss * (1.0f / 128.0f) + EPS);
    if (rb < TB) { const float* gn = p.gla_norm + (size_t)l * 512 + h * 128;
#pragma unroll
        for (int nt = 0; nt < 8; ++nt) { const int dv = nt * 16 + 4 * fq; const f32x4 gv = *(const f32x4*)(gn + dv); const u32x2 rw = rwv[nt];
            const float v0 = o[nt][0] * rstd * gv[0] * siluf_(bflo(rw.x)), v1 = o[nt][1] * rstd * gv[1] * siluf_(bfhi(rw.x)),
                        v2 = o[nt][2] * rstd * gv[2] * siluf_(bflo(rw.y)), v3 = o[nt][3] * rstd * gv[3] * siluf_(bfhi(rw.y));
            u32x2 w; w.x = cvt_pk_bf16(v0, v1); w.y = cvt_pk_bf16(v2, v3); if (!p.dry) *(u32x2*)(rowp + C_V + h * 128 + dv) = w; } }
}

__device__ __forceinline__ int mix_item(int r, int bid, int nblk) {
    const int pos = r * nblk + ((r & 1) ? nblk - 1 - bid : bid);
    if (pos >= S5_ITEMS + GLA_ITEMS) return -1;
    if (pos < 32) return 480 + pos;
    if (pos < S5_ITEMS) return pos - 32;
    return pos;
}
__device__ void tail_glu(const Params& p, int l, LAS unsigned char* lds) {
    const int t = otid(), w = t >> 6, lane = t & 63, fr = lane & 15, fq = lane >> 4, nt = w & 1, kq = w >> 1;
    bf16_t* proj = (bf16_t*)(p.ws + WS_PROJ); const bf16_t* Bt = (const bf16_t*)(p.ws + WS_W) + W_GLU;
    for (int piece = p.bid; piece < 256; piece += p.nblk) {
        const int row = MP - 256 + (piece >> 4) * 16 + fr, colw = (piece & 15) * 32 + nt * 16;
        bf16x8 a[4], b[4];
#pragma unroll
        for (int ks = 0; ks < 4; ++ks) { a[ks] = *(const bf16x8*)(proj + (size_t)row * NPROJ + C_U + kq * 128 + ks * 32 + fq * 8); b[ks] = *(const bf16x8*)(Bt + (size_t)(colw + fr) * 512 + kq * 128 + ks * 32 + fq * 8); }
        const int col = colw + 4 * fq;
        const u32x2 aw = *(const u32x2*)(proj + (size_t)row * NPROJ + C_U + col); const f32x4 bias = *(const f32x4*)(p.b_glu + (size_t)l * 512 + col);
        f32x4 acc = (f32x4){0.f, 0.f, 0.f, 0.f};
#pragma unroll
        for (int ks = 0; ks < 4; ++ks) acc = mfma16(b[ks], a[ks], acc);
        __syncthreads();
        *(LAS f32x4*)(lds + (w * 64 + lane) * 16) = acc;
        __syncthreads();
        if (w < 2) { f32x4 s = acc;
#pragma unroll
            for (int q = 1; q < 4; ++q) s += *(const LAS f32x4*)(lds + ((nt + 2 * q) * 64 + lane) * 16);
            const f32x4 act = (f32x4){bflo(aw.x), bfhi(aw.x), bflo(aw.y), bfhi(aw.y)}, o = act * sig4(s + bias);
            u32x2 ow; ow.x = cvt_pk_bf16(o[0], o[1]); ow.y = cvt_pk_bf16(o[2], o[3]); *(u32x2*)(proj + (size_t)row * NPROJ + C_GLU + col) = ow; }
    }
    __syncthreads();
}
__device__ void tail_mix(const Params& p, LAS unsigned char* lds) {
    const int t = otid(), w = t >> 6, lane = t & 63, fr = lane & 15, fq = lane >> 4, nt = w & 3, which = w >> 2;
    const bf16_t* proj = (const bf16_t*)(p.ws + WS_PROJ); const bf16_t* Bt = (const bf16_t*)(p.ws + WS_W) + (which ? W_PB : W_PA);
    bf16_t* mixed = (bf16_t*)((unsigned char*)p.out + OS_Z);
    for (int piece = p.bid; piece < 256; piece += p.nblk) {
        const int row = MP - 256 + (piece >> 4) * 16 + fr, colw = (piece & 15) * 64 + nt * 16, col = colw + 4 * fq;
        const bf16_t* ap = proj + (size_t)row * NPROJ + (which ? C_V : C_GLU); const bf16_t* bp = Bt + (size_t)(colw + fr) * 512;
        const u32x2 gaw = *(const u32x2*)(proj + (size_t)row * NPROJ + C_GA + col), gbw = *(const u32x2*)(proj + (size_t)row * NPROJ + C_GB + col);
        f32x4 acc = (f32x4){0.f, 0.f, 0.f, 0.f};
#pragma unroll
        for (int half = 0; half < 2; ++half) { bf16x8 a[8], b[8];
#pragma unroll
            for (int ks = 0; ks < 8; ++ks) { a[ks] = *(const bf16x8*)(ap + half * 256 + ks * 32 + fq * 8); b[ks] = *(const bf16x8*)(bp + half * 256 + ks * 32 + fq * 8); }
#pragma unroll
            for (int ks = 0; ks < 8; ++ks) acc = mfma16(b[ks], a[ks], acc); }
        __syncthreads();
        if (which) *(LAS f32x4*)(lds + (nt * 64 + lane) * 16) = acc;
        __syncthreads();
        if (!which) { const f32x4 accb = *(const LAS f32x4*)(lds + (nt * 64 + lane) * 16);
            const f32x4 ga = (f32x4){bflo(gaw.x), bfhi(gaw.x), bflo(gaw.y), bfhi(gaw.y)}, gb = (f32x4){bflo(gbw.x), bfhi(gbw.x), bflo(gbw.y), bfhi(gbw.y)};
            const f32x4 o = acc * sig4(ga) + accb * sig4(gb);
            u32x2 ow; ow.x = cvt_pk_bf16(o[0], o[1]); ow.y = cvt_pk_bf16(o[2], o[3]); *(u32x2*)(mixed + (size_t)row * DM + col) = ow; }
    }
    __syncthreads();
}

#define XB_TMO      128
#define XB_XCNT(j)  (256  + 64 * (j))
#define XB_XSUB(j)  (1280 + 64 * (j))
#define XB_XGEN(j)  (2304 + 64 * (j))
#define XB_TOP      3328
#define XB_TOPGEN   3392
#define XCD_BAR_WORDS 3456
#define XB_SPIN_CAP (1u << 20)
__device__ __forceinline__ unsigned xb_ld(unsigned* p)              { return __hip_atomic_load(p, __ATOMIC_RELAXED, __HIP_MEMORY_SCOPE_AGENT); }
__device__ __forceinline__ unsigned xb_add(unsigned* p, unsigned v) { return __hip_atomic_fetch_add(p, v, __ATOMIC_RELAXED, __HIP_MEMORY_SCOPE_AGENT); }
__device__ __forceinline__ unsigned xb_xcc_id() { return (unsigned)__builtin_amdgcn_s_getreg((3 << 11) | 20) & 0xFu; }
#define XB_SPIN(cond, bar) do { unsigned _sp = 0; while (cond) { __builtin_amdgcn_s_sleep(1); \
    if ((++_sp & 255u) == 0u) { if (xb_ld(&(bar)[XB_TMO])) break; if (_sp > XB_SPIN_CAP) { atomicAdd(&(bar)[XB_TMO], 1u); break; } } } } while (0)
struct XcdBarrier { unsigned* bar; unsigned x; volatile LAS unsigned* st; };
__device__ __forceinline__ XcdBarrier xcd_barrier_post(unsigned* bar, volatile LAS unsigned* st) {
    XcdBarrier b; b.bar = bar; b.x = xb_xcc_id(); b.st = st;
    if (threadIdx.x == 0) (void)xb_add(&bar[XB_XCNT(b.x)], 1u);
    return b;
}
__device__ __forceinline__ void xcd_barrier_complete(unsigned* bar, unsigned x, unsigned& nloc, unsigned& nx) {
    const unsigned G = gridDim.x * gridDim.y * gridDim.z;
    unsigned sum, cnt, mine, sp = 0u;
    for (;;) {
        sum = 0u; cnt = 0u; mine = 0u;
#pragma unroll
        for (unsigned j = 0; j < 16; ++j) { const unsigned c = xb_ld(&bar[XB_XCNT(j)]); sum += c; cnt += (c > 0u) ? 1u : 0u; mine = (j == x) ? c : mine; }
        if (sum == G) break;
        __builtin_amdgcn_s_sleep(1);
        if ((++sp & 255u) == 0u) { if (xb_ld(&bar[XB_TMO])) break; if (sp > XB_SPIN_CAP) { atomicAdd(&bar[XB_TMO], 1u); break; } }
    }
    nloc = mine > 0u ? mine : 1u; nx = cnt > 0u ? cnt : 1u;
}
__device__ __forceinline__ void xcd_barrier(const XcdBarrier& b) {
    asm volatile("s_waitcnt vmcnt(0)" ::: "memory");
    __syncthreads();
    if (threadIdx.x == 0) {
        unsigned* bar = b.bar;
        __builtin_amdgcn_s_waitcnt(0);
        unsigned nloc = b.st[0], nx = b.st[1];
        if (nloc == 0u) { xcd_barrier_complete(bar, b.x, nloc, nx); b.st[0] = nloc; b.st[1] = nx; }
        const unsigned old = xb_add(&bar[XB_XSUB(b.x)], 1u);
        const unsigned gen = old / nloc;
        if (old + 1u == (gen + 1u) * nloc) {
            __builtin_amdgcn_fence(__ATOMIC_RELEASE, "agent");
            asm volatile("s_waitcnt vmcnt(0)" ::: "memory");
            const unsigned og = xb_add(&bar[XB_TOP], 1u);
            const unsigned tg = og / nx;
            if (og + 1u == (tg + 1u) * nx) xb_add(&bar[XB_TOPGEN], 1u);
            else { unsigned _sp = 0; while (xb_ld(&bar[XB_TOPGEN]) == tg) { if ((++_sp & 1023u) == 0u) { if (xb_ld(&bar[XB_TMO])) break; if (_sp > (1u << 24)) { atomicAdd(&bar[XB_TMO], 1u); break; } } } }
            __builtin_amdgcn_fence(__ATOMIC_ACQUIRE, "agent");
            xb_add(&bar[XB_XGEN(b.x)], 1u);
            asm volatile("s_waitcnt vmcnt(0)" ::: "memory");
        } else {
            XB_SPIN(xb_ld(&bar[XB_XGEN(b.x)]) == gen, bar);
            __builtin_amdgcn_fence(__ATOMIC_ACQUIRE, "agent");
            asm volatile("s_waitcnt vmcnt(0)" ::: "memory");
        }
    }
    __syncthreads();
}

constexpr int NPHASE = 2 + 11 * DEPTH;
__device__ void run_phase(const Params& p, int ph, LAS unsigned char* lds) {
    bf16_t* hres = (bf16_t*)(p.ws + WS_H);
    bf16_t* proj = (bf16_t*)(p.ws + WS_PROJ);
    bf16_t* W = (bf16_t*)(p.ws + WS_W);
    bf16_t* z = (bf16_t*)((unsigned char*)p.out + OS_Z);
    bf16_t* hy = (bf16_t*)(p.ws + WS_Y);
    float* ssq1 = (float*)(p.ws + WS_SSQ1); float* ssq2 = (float*)(p.ws + WS_SSQ2); float* rs1 = (float*)(p.ws + WS_RS1); float* rs2 = (float*)(p.ws + WS_RS2);
    float* ldsf = (float*)(unsigned char*)lds;
    pg8::StaticOrder S;
    if (ph == 0) {
        for (int it = p.bid; it < NCONV_MIX + 256; it += p.nblk) { if (it < NCONV_MIX) conv_mixer_item(p, 0, it, ldsf); else s5_prep_item(p, 0, it - NCONV_MIX, ldsf); }
        init_h(p); return; }
    if (ph == NPHASE - 1) { final_norm(p, hres, p.norm_f, p.out); return; }
    const int l = (ph - 1) / 11, s = (ph - 1) % 11;
    if (l >= MK_LAYERS || s > MK_LAST_S) return;
    switch (s) {
    case 0:
        if (l > 0) fold_rows(p, 11, ssq1, rs1);
        break;
    case 1: { S.init(MP, NPROJ, 1024, p.nblk, p.bid); pg8::gemm_phase(lds, pg8::Gemm{hres, W + W_IN, MP, NPROJ, 1024, 1024, nullptr, nullptr}, S, EpiStore{proj, NPROJ, rs1}); }
        { const int first = (MP / 256 * (NPROJ / 256)) % p.nblk;
          if (p.bid >= first && first > 0) for (int it = p.bid - first; it < 352; it += p.nblk - first) conv_ff_item(p, l, it, ldsf); else if (first == 0) for (int it = p.bid; it < 352; it += p.nblk) conv_ff_item(p, l, it, ldsf); }
        break;
    case 2:
        for (int it = p.bid; it < S5_ITEMS + GLA_ITEMS; it += p.nblk) { if (it < S5_ITEMS) s5a_item(p, it, lds); else gla1_item(p, l, it - S5_ITEMS, lds); }
        break;
    case 3:
        if (otid() < 64) s5_scan(p);
#if !MK_NO_GSCAN
        else gla_scan(p);
#endif
        break;
    case 4:
        for (int it = p.bid; it < S5_ITEMS + GLA_ITEMS; it += p.nblk) { if (it < S5_ITEMS) s5c_item(p, l, it, lds); else gla3_item(p, l, it - S5_ITEMS, lds); }
        break;
    case 5: { tail_glu(p, l, lds); S.init(MP - 256, 512, 512, p.nblk, p.bid); pg8::gemm_phase(lds, pg8::Gemm{proj + C_U, W + W_GLU, MP - 256, 512, 512, NPROJ, nullptr, nullptr}, S, EpiGlu{proj, p.b_glu + (size_t)l * 512}); }
        if (l + 1 < DEPTH) for (int it = p.bid; it < 256; it += p.nblk) s5_prep_item(p, l + 1, it, ldsf);
        break;
    case 6: { tail_mix(p, lds); S.init(MP - 256, 1024, 512, p.nblk, p.bid, 0, 1);
        pg8::gemm_phase(lds, pg8::Gemm{proj + C_GLU, W + W_PA, MP - 256, 1024, 512, NPROJ, proj + C_V, W + W_PB}, S, EpiMixPair{proj + C_GA, proj + C_GB, z}); } break;
    case 7: { S.init(MP, 1024, 1024, p.nblk, p.bid, 4); pg8::gemm_phase(lds, pg8::Gemm{z, W + W_OUT, MP, 1024, 1024, 1024, nullptr, nullptr}, S, EpiRes{hres, p.dry ? 0.f : 1.f, (float*)(p.ws + WS_PART), ssq2}); }
        break;
    case 8:
        fold_rows(p, 4, ssq2, rs2); break;
    case 9: { S.init(MP, 2 * DFF, 1024, p.nblk, p.bid); pg8::gemm_phase(lds, pg8::Gemm{hres, W + W_FF13, MP, 2 * DFF, 1024, 1024, nullptr, nullptr}, S, EpiFF{proj, rs2}); }
        { const int first = (MP / 256 * (2 * DFF / 256)) % p.nblk, nmix = l + 1 < DEPTH ? NCONV_MIX : 0;
          const int i0 = first > 0 ? p.bid - first : p.bid, st = first > 0 ? p.nblk - first : p.nblk;
          if (i0 >= 0) for (int it = i0; it < nmix + 176; it += st) { if (it < nmix) conv_mixer_item(p, l + 1, it, ldsf); else conv_ff_item(p, l, 352 + it - nmix, ldsf); } }
        break;
    case 10: { S.init(MP, 1024, DFF, p.nblk, p.bid, 11); pg8::gemm_phase(lds, pg8::Gemm{proj, W + W_FF2, MP, 1024, DFF, DFF, nullptr, nullptr}, S, EpiRes{hres, p.dry ? 0.f : 1.f, (float*)(p.ws + WS_PART), ssq1}); }
        break;
    }
}

typedef const float* fptr_t;
typedef __attribute__((address_space(4))) const fptr_t kfptr_t;
__global__ void __launch_bounds__(512, 2) hybrid_fwd(Params p0) {
    extern __shared__ __attribute__((aligned(16))) unsigned char shm[];
    LAS unsigned char* lds = (LAS unsigned char*)shm;
    cg::grid_group grid = cg::this_grid();
    const int ph_lo = p0.ph_lo, ph_hi = p0.ph_hi;
    volatile LAS unsigned* xst = (volatile LAS unsigned*)(lds + 131072);
    if (threadIdx.x == 0) { xst[0] = 0u; xst[1] = 0u; }
    __syncthreads();
    XcdBarrier xb = xcd_barrier_post((unsigned*)(p0.ws + WS_BAR), xst);
    for (int ph = ph_lo; ph < ph_hi; ++ph) {
        if (ph == 1 && MK_ONE_LAUNCH) continue;
        int reps = (MK_DUP >= 0 && ph >= 1 && ph < NPHASE - 1 && (ph - 1) % 11 == MK_DUP) ? 2 : 1;
        for (int rep = 0; rep < reps; ++rep) {
        kfptr_t* tab = (kfptr_t*)__builtin_amdgcn_kernarg_segment_ptr(); asm volatile("" : "+s"(tab));
        Params p;
        p.x = tab[0]; p.meta = tab[1]; p.norm1 = tab[2]; p.w_in = tab[3]; p.lam_re = tab[4]; p.lam_im = tab[5]; p.log_step = tab[6]; p.b_re = tab[7]; p.b_im = tab[8];
        p.c_re = tab[9]; p.c_im = tab[10]; p.d_skip = tab[11]; p.w_glu = tab[12]; p.b_glu = tab[13]; p.w_pa = tab[14]; p.w_alpha = tab[15]; p.b_alpha = tab[16];
        p.gla_norm = tab[17]; p.w_pb = tab[18]; p.w_out = tab[19]; p.norm2 = tab[20]; p.w_ff1 = tab[21]; p.w_ff3 = tab[22]; p.w_ff2 = tab[23]; p.norm_f = tab[24];
        p.out = (float*)tab[25]; p.ws = (unsigned char*)tab[26]; p.ph_lo = ph_lo; p.ph_hi = ph_hi;
        int bid = blockIdx.x, nblk = gridDim.x; asm volatile("" : "+s"(bid)); asm volatile("" : "+s"(nblk));
        p.bid = bid; p.nblk = nblk; p.dry = (reps == 2 && rep == 0 && MK_DUP_DRY) ? 1 : 0; p.pad_ = 0;
        run_phase(p, ph, lds);
        if (rep + 1 < reps || ph + 1 < ph_hi) {
            if (ph == ph_lo && rep == 0) grid.sync();
            else { xb.bar = (unsigned*)(p.ws + WS_BAR); xcd_barrier(xb); } }
        if (MK_DUP == 99) { xb.bar = (unsigned*)(p.ws + WS_BAR); xcd_barrier(xb); }
        }
    }
}

extern "C" void kernel_launch(void* const* d_in, const int* in_sizes, int n_in, void* d_out, int out_size, void* d_ws, size_t ws_size, hipStream_t stream) {
    static int grid = 0;
    if (grid == 0) {
        if (n_in != 25 || ws_size < WS_END) { fprintf(stderr, "kernel_launch: unexpected n_in %d or ws_size %zu (< %zu)\n", n_in, ws_size, (size_t)WS_END); grid = -1; return; }
        int dev = 0, cus = 0, per_cu = 0;
        hipGetDevice(&dev); hipDeviceGetAttribute(&cus, hipDeviceAttributeMultiprocessorCount, dev);
        if (hipFuncSetAttribute((const void*)hybrid_fwd, hipFuncAttributeMaxDynamicSharedMemorySize, LDS_BYTES) != hipSuccess) { fprintf(stderr, "kernel_launch: hipFuncSetAttribute failed\n"); grid = -1; return; }
        if (hipOccupancyMaxActiveBlocksPerMultiprocessor(&per_cu, (const void*)hybrid_fwd, 512, LDS_BYTES) != hipSuccess || per_cu < 1) { fprintf(stderr, "kernel_launch: occupancy query says %d\n", per_cu); per_cu = 1; }
        (void)hipGetLastError();
        grid = cus * per_cu;
    }
    if (grid < 0) return;
    Params p{};
    const float** pp = (const float**)&p;
    for (int i = 0; i < 25; ++i) pp[i] = (const float*)d_in[i];
    p.out = (float*)d_out; p.ws = (unsigned char*)d_ws;
#if MK_ONE_LAUNCH
    p.ph_lo = 0; p.ph_hi = NPHASE;
    (void)hipMemsetAsync((char*)d_ws + WS_BAR, 0, 16384, stream);
    void* args[] = {&p};
    hipError_t e = hipLaunchCooperativeKernel((const void*)hybrid_fwd, dim3(grid), dim3(512), args, LDS_BYTES, stream);
    if (e != hipSuccess) fprintf(stderr, "cooperative launch failed: %s (grid %d)\n", hipGetErrorString(e), grid);
#else
    for (int ph = 0; ph < NPHASE; ++ph) { p.ph_lo = ph; p.ph_hi = ph + 1; hipLaunchKernelGGL(hybrid_fwd, dim3(grid), dim3(512), LDS_BYTES, stream, p); }
#endif
}
```
